# Optimizing an MI355X kernel written in HIP

```python
import jax, jax.numpy as jnp
from jax import lax
import numpy as np

D_MODEL = 2048
BATCH = 2
SEQ = 4096
DEPTH = 1

HEAD_DIM = 128
ATTN_WIDTH = D_MODEL // 2
CONV_WIDTH = D_MODEL - ATTN_WIDTH
N_Q_HEADS = ATTN_WIDTH // HEAD_DIM
N_KV_HEADS = max(1, N_Q_HEADS // 4)
KV_WIDTH = N_KV_HEADS * HEAD_DIM
CONV_GROUPS = CONV_WIDTH // HEAD_DIM
WINDOW = 128
BLOCK = 128
CONV_K = 3
D_FF = ((8 * D_MODEL // 3 + 255) // 256) * 256
EPS = 1e-6
NEG_INF = -1e30
SPLIT_SIZES = (ATTN_WIDTH, KV_WIDTH, KV_WIDTH, CONV_WIDTH, CONV_WIDTH, CONV_WIDTH)
IN_WIDTH = sum(SPLIT_SIZES)

kernel_name = "hymba_swa_alibi_shortconv_convffn_encoder"


def rms_norm(x, w):
    xf = x.astype(jnp.float32)
    y = xf * lax.rsqrt(jnp.mean(xf * xf, axis=-1, keepdims=True) + EPS)
    return (y * w.astype(jnp.float32)).astype(x.dtype)


def dwconv3(u, w, b):
    up = jnp.pad(u, ((0, 0), (1, 1), (0, 0)))
    return up[:, :-2] * w[0] + up[:, 1:-1] * w[1] + up[:, 2:] * w[2] + b


def alibi_slopes(n_heads):
    return jnp.asarray(2.0 ** (-8.0 * np.arange(1, n_heads + 1) / n_heads), dtype=jnp.float32)


def banded_attention(q, k, v, sinks):
    bsz, s = q.shape[0], q.shape[1]
    nb = s // BLOCK
    g = N_Q_HEADS // N_KV_HEADS
    qb = q.reshape(bsz, nb, BLOCK, N_KV_HEADS, g, HEAD_DIM)

    def band(t):
        tp = jnp.pad(t, ((0, 0), (BLOCK, BLOCK), (0, 0), (0, 0)))
        tp = tp.reshape(bsz, nb + 2, BLOCK, N_KV_HEADS, HEAD_DIM)
        return jnp.concatenate([tp[:, :-2], tp[:, 1:-1], tp[:, 2:]], axis=2)

    kb, vb = band(k), band(v)
    scale = HEAD_DIM ** -0.5
    scores = jnp.einsum('bnqhgd,bnkhd->bnhgqk', qb, kb,
                        preferred_element_type=jnp.float32) * scale

    qi = jnp.arange(BLOCK)[:, None]
    kj = jnp.arange(3 * BLOCK)[None, :]
    rel = kj - BLOCK - qi
    s_pos = jnp.arange(nb)[:, None, None] * BLOCK + kj[None] - BLOCK
    valid = (jnp.abs(rel) <= WINDOW)[None] & (s_pos >= 0) & (s_pos < s)

    slopes = alibi_slopes(N_Q_HEADS).reshape(N_KV_HEADS, g)
    bias = -slopes[:, :, None, None] * jnp.abs(rel).astype(jnp.float32)
    scores = jnp.where(valid[None, :, None, None], scores + bias[None, None], NEG_INF)

    sink = jnp.broadcast_to(sinks.astype(jnp.float32).reshape(1, 1, N_KV_HEADS, g, 1, 1),
                            scores.shape[:-1] + (1,))
    probs = jax.nn.softmax(jnp.concatenate([scores, sink], axis=-1), axis=-1)[..., :-1]
    out = jnp.einsum('bnhgqk,bnkhd->bnqhgd', probs.astype(v.dtype), vb)
    return out.reshape(bsz, s, ATTN_WIDTH)


def setup_inputs(seed: int = 0) -> dict:
    key = jax.random.key(seed)
    ks = jax.random.split(key, 17)
    f32 = jnp.float32
    nrm = lambda k, shape, sc: jax.random.normal(k, shape, f32) * sc
    gain = lambda k, shape: 1.0 + 0.02 * jax.random.normal(k, shape, f32)
    return {
        "x": jax.random.normal(ks[0], (BATCH, SEQ, D_MODEL), f32),
        "attn_norm_w": gain(ks[1], (DEPTH, D_MODEL)),
        "w_in": nrm(ks[2], (DEPTH, D_MODEL, IN_WIDTH), D_MODEL ** -0.5),
        "sink_logits": nrm(ks[3], (DEPTH, N_Q_HEADS), 0.5),
        "mix_conv_w": nrm(ks[4], (DEPTH, CONV_K, CONV_WIDTH), CONV_K ** -0.5),
        "mix_conv_b": nrm(ks[5], (DEPTH, CONV_WIDTH), 0.02),
        "attn_out_norm_w": gain(ks[6], (DEPTH, ATTN_WIDTH)),
        "conv_out_norm_w": gain(ks[7], (DEPTH, CONV_WIDTH)),
        "w_out": nrm(ks[8], (DEPTH, D_MODEL, D_MODEL), D_MODEL ** -0.5),
        "ffn_norm_w": gain(ks[9], (DEPTH, D_MODEL)),
        "w_gate": nrm(ks[10], (DEPTH, D_MODEL, D_FF), D_MODEL ** -0.5),
        "w_up": nrm(ks[11], (DEPTH, D_MODEL, D_FF), D_MODEL ** -0.5),
        "ffn_conv_w": nrm(ks[12], (DEPTH, CONV_K, D_FF), CONV_K ** -0.5),
        "ffn_conv_b": nrm(ks[13], (DEPTH, D_FF), 0.02),
        "w_down": nrm(ks[14], (DEPTH, D_FF, D_MODEL), D_FF ** -0.5),
        "final_norm_w": gain(ks[15], (D_MODEL,)),
    }


def reference(x, attn_norm_w, w_in, sink_logits, mix_conv_w, mix_conv_b,
              attn_out_norm_w, conv_out_norm_w, w_out, ffn_norm_w, w_gate, w_up,
              ffn_conv_w, ffn_conv_b, w_down, final_norm_w):
    bsz, s = x.shape[0], x.shape[1]
    split_idx = [int(i) for i in np.cumsum(SPLIT_SIZES)[:-1]]
    for l in range(DEPTH):
        h = rms_norm(x, attn_norm_w[l])
        proj = h @ w_in[l]
        q, k, v, gate_b, gate_c, u = jnp.split(proj, split_idx, axis=-1)
        attn = banded_attention(q.reshape(bsz, s, N_Q_HEADS, HEAD_DIM),
                                k.reshape(bsz, s, N_KV_HEADS, HEAD_DIM),
                                v.reshape(bsz, s, N_KV_HEADS, HEAD_DIM),
                                sink_logits[l])
        conv = gate_b * dwconv3(gate_c * u, mix_conv_w[l], mix_conv_b[l])
        mixed = jnp.concatenate([rms_norm(attn, attn_out_norm_w[l]),
                                 rms_norm(conv, conv_out_norm_w[l])], axis=-1)
        x = x + mixed @ w_out[l]
        h = rms_norm(x, ffn_norm_w[l])
        g = dwconv3(h @ w_gate[l], ffn_conv_w[l], ffn_conv_b[l])
        x = x + (jax.nn.silu(g) * (h @ w_up[l])) @ w_down[l]
    return rms_norm(x, final_norm_w)
```

```cpp
#include <hip/hip_runtime.h>
#include <hip/hip_cooperative_groups.h>
#include <cstdio>
#include <cstdint>
namespace cg = cooperative_groups;

#define LAS __attribute__((address_space(3)))
typedef unsigned short bf16_t;
typedef short bf16x8 __attribute__((ext_vector_type(8)));
typedef short s16x4 __attribute__((ext_vector_type(4)));
typedef float f32x4 __attribute__((ext_vector_type(4)));
typedef float f32x2 __attribute__((ext_vector_type(2)));
typedef float f32x16 __attribute__((ext_vector_type(16)));
typedef unsigned u32x4 __attribute__((ext_vector_type(4)));
typedef unsigned u32x2 __attribute__((ext_vector_type(2)));

constexpr int SEQ = 4096, MTOK = 8192, DM = 2048, INW = 4608, FF = 5632;
constexpr int COL_K = 1024, COL_B = 1536, COL_C = 2560, COL_U = 3584;
constexpr float EPS = 1e-6f, LOG2E = 1.4426950408889634f;
constexpr int NTHR = 512, LDS_BYTES = 147456;
constexpr size_t MiB = 1u << 20;
constexpr size_t WS_WOUT = 0, WS_WGU = 8 * MiB, WS_WD = 52 * MiB, WS_WIN = 74 * MiB, WS_H = 92 * MiB  , WS_PROJ = 124 * MiB;
constexpr size_t WS_ACT = 74 * MiB  , WS_X1B = 162 * MiB  , WS_SSQ = 200 * MiB, WS_CTL = 201 * MiB  , CTL_BYTES = 32768, WS_MIX = 204 * MiB  , WS_END = 236 * MiB;
static_assert(WS_ACT + (size_t)MTOK * FF * 2 <= WS_X1B && WS_X1B + (size_t)(MTOK + 2) * DM * 2 <= WS_PROJ + (size_t)MTOK * INW * 2 && WS_PROJ + (size_t)MTOK * INW * 2 <= WS_SSQ, "ws map");

__device__ __forceinline__ unsigned cvt_pk_bf16(float lo, float hi) { unsigned r; asm volatile("v_cvt_pk_bf16_f32 %0, %1, %2" : "=v"(r) : "v"(lo), "v"(hi)); return r; }
__device__ __forceinline__ float bf_lo(unsigned w) { return __uint_as_float(w << 16); }
__device__ __forceinline__ float bf_hi(unsigned w) { return __uint_as_float(w & 0xffff0000u); }
#define LDS_WAIT() asm volatile("s_waitcnt lgkmcnt(0)" ::: "memory")
__device__ __forceinline__ int opaque_v(int v) { asm volatile("" : "+v"(v)); return v; }

namespace pg8 {
constexpr int BM = 256, BK = 64, HALF = 128, HTB = HALF * BK * 2, STAGE_BYTES = 8 * HTB, NXCD = 8, WGM = 8;
__host__ __device__ __forceinline__ int lds_byte(int r, int c) { const int st = (r >> 4) * 2 + (c >> 5), rr = r & 15, cc = c & 31, ob = rr * 64 + cc * 2; return st * 1024 + (ob ^ (((ob >> 9) & 1) << 5)); }
__host__ __device__ __forceinline__ void stage_rc(int b, int& R, int& C) { const int st = b / 1024, sb = b % 1024, swz = sb ^ (((sb >> 9) & 1) << 5); R = (st >> 1) * 16 + swz / 64; C = (st & 1) * 32 + (swz % 64) / 2; }
__host__ __device__ __forceinline__ int perm32(int rho) { const int n = rho >> 4, i = rho & 15; return 8 * (i >> 2) + 4 * n + (i & 3); }

struct Unit { int pm, pn, arow; };
struct Gemm { const bf16_t* A; const bf16_t* Bt; int K; };

struct Order {
    int nM, nN, nwg, G, c, mode;
    __device__ void init(int nM_, int nN_, int G_, int c_, int mode_) { nM = nM_; nN = nN_; nwg = nM * nN; G = G_; c = c_; mode = mode_; }
    __device__ bool next(int i, Unit& u) const {
        if (mode == 2 && i >= 2) {
            if (i > 2 || (c & 7) >= 2) return false;
            u.pn = (c & 7) == 0 ? 8 : 17; u.pm = c >> 3; u.arow = u.pm * BM; return true; }
        const long L = (long)i * G + c; if (L >= nwg) return false;
        int wgid = (int)L; { const int q = nwg / NXCD, r = nwg % NXCD, xcd = wgid % NXCD, off = wgid / NXCD; wgid = (xcd < r ? xcd * (q + 1) : r * (q + 1) + (xcd - r) * q) + off; }
        const int nig = WGM * nN, gid = wgid / nig, fm = gid * WGM, gsz = (nM - fm) < WGM ? (nM - fm) : WGM;
        u.pm = fm + ((wgid % nig) % gsz); u.pn = (wgid % nig) / gsz;
        if (mode != 1) u.arow = u.pm * BM;
        else { const int b = u.pm / 17, j = u.pm % 17; int T0 = 248 * j; if (T0 > 3848) T0 = 3848; u.arow = b * SEQ + T0 - 1; }
        return true;
    }
};

struct EpiBf16 {
    static constexpr bool AFTER_DRAIN = false;
    bf16_t* O; int ldc; const float* rs;
    __device__ __forceinline__ void operator()(const f32x4 (&acc)[2][2][4][2], const Unit& u, int wr, int wc, int fr, int fq) const {
        const int row0 = u.pm * BM + wr * 64 + fr, col0 = u.pn * BM + wc * 32 + 8 * fq;
        float rv[2][4];
#pragma unroll
        for (int ai = 0; ai < 2; ++ai)
#pragma unroll
            for (int m = 0; m < 4; ++m) rv[ai][m] = rs[row0 + ai * HALF + m * 16];
#pragma unroll
        for (int ai = 0; ai < 2; ++ai)
#pragma unroll
            for (int m = 0; m < 4; ++m) { bf16_t* rowp = O + (size_t)(row0 + ai * HALF + m * 16) * ldc + col0; const float r = rv[ai][m];
#pragma unroll
                for (int bj = 0; bj < 2; ++bj) { const f32x4 v0 = acc[ai][bj][m][0] * r, v1 = acc[ai][bj][m][1] * r;
                    u32x4 w; w.x = cvt_pk_bf16(v0[0], v0[1]); w.y = cvt_pk_bf16(v0[2], v0[3]); w.z = cvt_pk_bf16(v1[0], v1[1]); w.w = cvt_pk_bf16(v1[2], v1[3]);
                    *(u32x4*)(rowp + bj * HALF) = w; } }
    }
};
struct EpiRes1 {
    static constexpr bool AFTER_DRAIN = true;
    const bf16_t* base; bf16_t* xb; float* ssq; unsigned* cnt; float* r2out;
    __device__ __forceinline__ void fused(f32x4 (&acc)[2][2][4][2], const Unit& u, int wr, int wc, int fr, int fq, LAS unsigned char* lds, int wid, int lane) const {
        LAS float* P = (LAS float*)lds;
        const int col0 = u.pn * BM + wc * 32 + 8 * fq;
#pragma unroll
        for (int ai = 0; ai < 2; ++ai) {
            u32x4 pre[4][2];
#pragma unroll
            for (int m = 0; m < 4; ++m) { const size_t off = (size_t)(u.pm * BM + ai * HALF + wr * 64 + m * 16 + fr) * DM + col0;
#pragma unroll
                for (int bj = 0; bj < 2; ++bj) pre[m][bj] = *(const u32x4*)(base + off + bj * HALF); }
            asm volatile("" ::: "memory");
#pragma unroll
            for (int m = 0; m < 4; ++m) { const int rl = ai * HALF + wr * 64 + m * 16 + fr; const size_t off = (size_t)(u.pm * BM + rl) * DM + col0; float s = 0.f;
#pragma unroll
                for (int bj = 0; bj < 2; ++bj) { const u32x4 pw = pre[m][bj]; const f32x4 b0 = (f32x4){bf_lo(pw.x), bf_hi(pw.x), bf_lo(pw.y), bf_hi(pw.y)}, b1 = (f32x4){bf_lo(pw.z), bf_hi(pw.z), bf_lo(pw.w), bf_hi(pw.w)};
                    const f32x4 v0 = acc[ai][bj][m][0] + b0, v1 = acc[ai][bj][m][1] + b1;
                    u32x4 w; w.x = cvt_pk_bf16(v0[0], v0[1]); w.y = cvt_pk_bf16(v0[2], v0[3]); w.z = cvt_pk_bf16(v1[0], v1[1]); w.w = cvt_pk_bf16(v1[2], v1[3]);
                    *(u32x4*)(xb + off + bj * HALF) = w;
                    s += (v0[0] * v0[0] + v0[1] * v0[1]) + (v0[2] * v0[2] + v0[3] * v0[3]) + (v1[0] * v1[0] + v1[1] * v1[1]) + (v1[2] * v1[2] + v1[3] * v1[3]); }
                s += __shfl_xor(s, 16); s += __shfl_xor(s, 32);
                if (fq == 0) P[rl * 4 + wc] = s; }
            asm volatile("" ::: "memory");
        }
        __syncthreads();
        const int tid = wid * 64 + lane;
        if (tid < 256) __hip_atomic_store(ssq + (size_t)(u.pm * BM + tid) * 8 + u.pn, (P[tid * 4 + 0] + P[tid * 4 + 1]) + (P[tid * 4 + 2] + P[tid * 4 + 3]), __ATOMIC_RELAXED, __HIP_MEMORY_SCOPE_AGENT);
        asm volatile("s_waitcnt vmcnt(0)" ::: "memory");
        __syncthreads();
        LAS unsigned* flag = (LAS unsigned*)(lds + 4096);
        if (tid == 0) { const unsigned old = __hip_atomic_fetch_add(cnt + 64 * u.pm, 1u, __ATOMIC_RELAXED, __HIP_MEMORY_SCOPE_AGENT);
            if (old == 7u) { __builtin_amdgcn_fence(__ATOMIC_ACQUIRE, "agent"); asm volatile("s_waitcnt vmcnt(0)" ::: "memory"); }
            flag[0] = (old == 7u) ? 1u : 0u; }
        __syncthreads();
        if (flag[0] != 0u && tid < 256) { const float* sp8 = ssq + (size_t)(u.pm * BM + tid) * 8; float t = 0.f;
#pragma unroll
            for (int k = 0; k < 8; ++k) t += __hip_atomic_load(sp8 + k, __ATOMIC_RELAXED, __HIP_MEMORY_SCOPE_AGENT);
            r2out[u.pm * BM + tid] = __builtin_amdgcn_rsqf(t * (1.0f / DM) + EPS); }
    }
};
struct EpiFinal {
    static constexpr bool AFTER_DRAIN = true;
    const bf16_t* base; float* out; float* ssq2; unsigned* cnt; const float* w;
    __device__ __forceinline__ void fused(f32x4 (&acc)[2][2][4][2], const Unit& u, int wr, int wc, int fr, int fq, LAS unsigned char* lds, int wid, int lane) const {
        LAS float* P = (LAS float*)lds;
        LAS float* S = P + 1024;
        const int col0 = u.pn * BM + wc * 32 + 8 * fq;
        f32x4 wv[2][2];
#pragma unroll
        for (int bj = 0; bj < 2; ++bj) { wv[bj][0] = *(const f32x4*)(w + col0 + bj * HALF); wv[bj][1] = *(const f32x4*)(w + col0 + bj * HALF + 4); }
#pragma unroll
        for (int ai = 0; ai < 2; ++ai) {
            u32x4 pre[4][2];
#pragma unroll
            for (int m = 0; m < 4; ++m) { const size_t off = (size_t)(u.pm * BM + ai * HALF + wr * 64 + m * 16 + fr) * DM + col0;
#pragma unroll
                for (int bj = 0; bj < 2; ++bj) pre[m][bj] = *(const u32x4*)(base + off + bj * HALF); }
            asm volatile("" ::: "memory");
#pragma unroll
            for (int m = 0; m < 4; ++m) { const int rl = ai * HALF + wr * 64 + m * 16 + fr; float s = 0.f;
#pragma unroll
                for (int bj = 0; bj < 2; ++bj) { const u32x4 pw = pre[m][bj]; const f32x4 b0 = (f32x4){bf_lo(pw.x), bf_hi(pw.x), bf_lo(pw.y), bf_hi(pw.y)}, b1 = (f32x4){bf_lo(pw.z), bf_hi(pw.z), bf_lo(pw.w), bf_hi(pw.w)};
                    const f32x4 v0 = acc[ai][bj][m][0] + b0, v1 = acc[ai][bj][m][1] + b1; acc[ai][bj][m][0] = v0; acc[ai][bj][m][1] = v1;
                    s += (v0[0] * v0[0] + v0[1] * v0[1]) + (v0[2] * v0[2] + v0[3] * v0[3]) + (v1[0] * v1[0] + v1[1] * v1[1]) + (v1[2] * v1[2] + v1[3] * v1[3]); }
                s += __shfl_xor(s, 16); s += __shfl_xor(s, 32);
                if (fq == 0) P[rl * 4 + wc] = s; }
        }
        __syncthreads();
        const int tid = wid * 64 + lane;
        if (tid < 256) __hip_atomic_store(ssq2 + (size_t)(u.pm * BM + tid) * 8 + u.pn, (P[tid * 4 + 0] + P[tid * 4 + 1]) + (P[tid * 4 + 2] + P[tid * 4 + 3]), __ATOMIC_RELAXED, __HIP_MEMORY_SCOPE_AGENT);
        asm volatile("s_waitcnt vmcnt(0)" ::: "memory");
        __syncthreads();
        if (tid == 0) {
            unsigned* c = cnt + 64 * u.pm;
            __hip_atomic_fetch_add(c, 1u, __ATOMIC_RELAXED, __HIP_MEMORY_SCOPE_AGENT);
            unsigned sp = 0u;
            while (__hip_atomic_load(c, __ATOMIC_RELAXED, __HIP_MEMORY_SCOPE_AGENT) < 8u) { __builtin_amdgcn_s_sleep(2); if (++sp > (1u << 22)) break; }
            __builtin_amdgcn_fence(__ATOMIC_ACQUIRE, "agent");
            asm volatile("s_waitcnt vmcnt(0)" ::: "memory");
        }
        __syncthreads();
        if (tid < 256) { const float* sp8 = ssq2 + (size_t)(u.pm * BM + tid) * 8; float t = 0.f;
#pragma unroll
            for (int k = 0; k < 8; ++k) t += __hip_atomic_load(sp8 + k, __ATOMIC_RELAXED, __HIP_MEMORY_SCOPE_AGENT);
            S[tid] = 1.0f / sqrtf(t * (1.0f / DM) + EPS); }
        __syncthreads();
#pragma unroll
        for (int ai = 0; ai < 2; ++ai)
#pragma unroll
            for (int m = 0; m < 4; ++m) { const int rl = ai * HALF + wr * 64 + m * 16 + fr; const size_t off = (size_t)(u.pm * BM + rl) * DM + col0; const float r = S[rl];
#pragma unroll
                for (int bj = 0; bj < 2; ++bj) { *(f32x4*)(out + off + bj * HALF) = acc[ai][bj][m][0] * r * wv[bj][0]; *(f32x4*)(out + off + bj * HALF + 4) = acc[ai][bj][m][1] * r * wv[bj][1]; } }
    }
};
struct EpiFfn {
    static constexpr bool AFTER_DRAIN = false;
    bf16_t* act; const float* r2; const float* cw; const float* cb;
    __device__ __forceinline__ void operator()(f32x4 (&acc)[2][2][4][2], const Unit& u, int wr, int wc, int fr, int fq) const {
        const int b = u.pm / 17, j = u.pm % 17; int T0 = 248 * j; if (T0 > 3848) T0 = 3848;
        const int ch0 = u.pn * HALF + wc * 32 + 8 * fq;
        float r2v[2][4]; int tt[2][4];
#pragma unroll
        for (int ai = 0; ai < 2; ++ai)
#pragma unroll
            for (int m = 0; m < 4; ++m) { const int t = T0 + 62 * (2 * ai + wr) + 16 * m + fr - 1; tt[ai][m] = t; const int tc = t < 0 ? 0 : (t > SEQ - 1 ? SEQ - 1 : t); r2v[ai][m] = r2[b * SEQ + tc]; }
        f32x4 w0[2], w1[2], w2[2], bb[2];
#pragma unroll
        for (int n = 0; n < 2; ++n) { w0[n] = *(const f32x4*)(cw + ch0 + 4 * n); w1[n] = *(const f32x4*)(cw + FF + ch0 + 4 * n); w2[n] = *(const f32x4*)(cw + 2 * FF + ch0 + 4 * n); bb[n] = *(const f32x4*)(cb + ch0 + 4 * n); }
        asm volatile("" ::: "memory");
        const bool edge = (j == 0) || (j == 16);
        if (edge) {
#pragma unroll
            for (int ai = 0; ai < 2; ++ai)
#pragma unroll
                for (int m = 0; m < 4; ++m) if (tt[ai][m] < 0 || tt[ai][m] > SEQ - 1) { acc[ai][0][m][0] = (f32x4){0.f, 0.f, 0.f, 0.f}; acc[ai][0][m][1] = (f32x4){0.f, 0.f, 0.f, 0.f}; } }
        body<false>(acc, r2v, tt, w0, w1, w2, bb, b, ch0, fr);
    }
    template <bool EDGE> __device__ __forceinline__ void body(f32x4 (&acc)[2][2][4][2], const float (&r2v)[2][4], const int (&tt)[2][4], const f32x4 (&w0)[2], const f32x4 (&w1)[2], const f32x4 (&w2)[2], const f32x4 (&bb)[2], int b, int ch0, int fr) const {
#pragma unroll
        for (int ai = 0; ai < 2; ++ai) {
#pragma unroll
            for (int m = 0; m < 4; ++m) { const float r = r2v[ai][m];
#pragma unroll
                for (int n = 0; n < 2; ++n) { acc[ai][0][m][n] = acc[ai][0][m][n] * r; acc[ai][1][m][n] = acc[ai][1][m][n] * r; } }
            unsigned res[4][4];
#pragma unroll
            for (int n = 0; n < 2; ++n) {
#pragma unroll
                for (int ep = 0; ep < 2; ++ep) {
                    const f32x2 w0p = {w0[n][2 * ep], w0[n][2 * ep + 1]}, w1p = {w1[n][2 * ep], w1[n][2 * ep + 1]}, w2p = {w2[n][2 * ep], w2[n][2 * ep + 1]}, bbp = {bb[n][2 * ep], bb[n][2 * ep + 1]};
#pragma unroll
                    for (int m = 0; m < 4; ++m) {
                        const f32x2 g = {acc[ai][0][m][n][2 * ep], acc[ai][0][m][n][2 * ep + 1]};
                        const f32x2 gm = {acc[ai][0][m > 0 ? m - 1 : 0][n][2 * ep], acc[ai][0][m > 0 ? m - 1 : 0][n][2 * ep + 1]}, gp = {acc[ai][0][m < 3 ? m + 1 : 3][n][2 * ep], acc[ai][0][m < 3 ? m + 1 : 3][n][2 * ep + 1]};
                        const bool selp = (fr == 15 && m > 0), seln = (fr == 0 && m < 3);
                        const float ps0 = selp ? gm[0] : g[0], ps1 = selp ? gm[1] : g[1], ns0 = seln ? gp[0] : g[0], ns1 = seln ? gp[1] : g[1];
                        f32x2 prev, next;
                        prev[0] = __int_as_float(__builtin_amdgcn_update_dpp(0, __float_as_int(ps0), 0x121  , 0xF, 0xF, false));
                        prev[1] = __int_as_float(__builtin_amdgcn_update_dpp(0, __float_as_int(ps1), 0x121, 0xF, 0xF, false));
                        next[0] = __int_as_float(__builtin_amdgcn_update_dpp(0, __float_as_int(ns0), 0x12F  , 0xF, 0xF, false));
                        next[1] = __int_as_float(__builtin_amdgcn_update_dpp(0, __float_as_int(ns1), 0x12F, 0xF, 0xF, false));
                        const f32x2 gc = w0p * prev + (w1p * g + (w2p * next + bbp));
                        f32x2 ex = gc * (-LOG2E); ex[0] = __builtin_amdgcn_exp2f(ex[0]); ex[1] = __builtin_amdgcn_exp2f(ex[1]);
                        const f32x2 den = ex + 1.0f; f32x2 sg; sg[0] = __builtin_amdgcn_rcpf(den[0]); sg[1] = __builtin_amdgcn_rcpf(den[1]);
                        const f32x2 up = {acc[ai][1][m][n][2 * ep], acc[ai][1][m][n][2 * ep + 1]};
                        const f32x2 rs = gc * sg * up;
                        res[m][2 * n + ep] = cvt_pk_bf16(rs[0], rs[1]); } }
            }
#pragma unroll
            for (int m = 0; m < 4; ++m) { const int q = 16 * m + fr;
                if (q >= 1 && q <= 62) { u32x4 w; w.x = res[m][0]; w.y = res[m][1]; w.z = res[m][2]; w.w = res[m][3];
                    *(u32x4*)(act + (size_t)(b * SEQ + tt[ai][m]) * FF + ch0) = w; } }
        }
    }
};

template <class Epi, bool STRIP, bool ALIGN_EPI>
__device__ __forceinline__ void gemm_phase(LAS unsigned char* lds, const Gemm g, const Order& S, Epi& E) {
    const int tid = opaque_v(threadIdx.x), wid = __builtin_amdgcn_readfirstlane(tid >> 6), lane = tid & 63, wr = wid >> 2, wc = wid & 3, fr = lane & 15, fq = lane >> 4;
    const int K = g.K, nt = K / BK;
    unsigned voffA[2], voffB[2];
#pragma unroll
    for (int i = 0; i < 2; ++i) { int R, C; stage_rc(tid * 16 + i * 8192, R, C); const int Rb = (R & ~31) + perm32(R & 31); const int Ra = STRIP ? (62 * (R >> 6) + (R & 63)) : R;
        voffA[i] = (unsigned)(Ra * K + C) * 2u; voffB[i] = (unsigned)(Rb * K + C) * 2u; }
    const size_t kstep = (size_t)(BK * 2);
    const size_t hstepB = (size_t)HALF * K * 2, hstepA = (size_t)(STRIP ? 124 : HALF) * K * 2;
    const size_t tstepB = 2 * hstepB;
    const long rowb = (long)K * 2;
    const unsigned ldsw = (unsigned)wid * 1024u;
    const int aoff = lds_byte(wr * 64 + fr, fq * 8), boff = lds_byte(wc * 32 + fr, fq * 8);
#define PG8_SA(b, h) (((b) * 2 + (h)) * HTB)
#define PG8_SB(b, h) ((4 + (b) * 2 + (h)) * HTB)
#define PG8_STAGE(bufoff, gbase, voff) do { _Pragma("unroll") for (int _i = 0; _i < 2; ++_i) \
        __builtin_amdgcn_global_load_lds((const unsigned*)((const char*)(gbase) + (voff)[_i]), (LAS unsigned*)(lds + (bufoff) + ldsw + _i * 8192), 16, 0, 0); } while (0)
#define PG8_LDA(dst, b, h) do { _Pragma("unroll") for (int m = 0; m < 4; ++m) _Pragma("unroll") for (int k = 0; k < 2; ++k) dst[m][k] = *(const LAS bf16x8*)(lds + PG8_SA(b, h) + aoff + m * 2048 + k * 1024); } while (0)
#define PG8_LDB(dst, b, h) do { _Pragma("unroll") for (int n = 0; n < 2; ++n) _Pragma("unroll") for (int k = 0; k < 2; ++k) dst[n][k] = *(const LAS bf16x8*)(lds + PG8_SB(b, h) + boff + n * 2048 + k * 1024); } while (0)
#define PG8_MMA(ai, bj, At, Bt) do { __builtin_amdgcn_s_setprio(1); _Pragma("unroll") for (int m = 0; m < 4; ++m) _Pragma("unroll") for (int n = 0; n < 2; ++n) _Pragma("unroll") for (int k = 0; k < 2; ++k) \
        acc[ai][bj][m][n] = __builtin_amdgcn_mfma_f32_16x16x32_bf16(Bt[n][k], At[m][k], acc[ai][bj][m][n], 0, 0, 0); __builtin_amdgcn_s_setprio(0); } while (0)
#define PG8_WAIT_V(n) asm volatile("s_waitcnt vmcnt(" #n ")" ::: "memory")
#define PG8_WAIT_L(n) asm volatile("s_waitcnt lgkmcnt(" #n ")" ::: "memory")
#define PG8_BAR __builtin_amdgcn_s_barrier()
#define PG8_SCHED __builtin_amdgcn_sched_barrier(0)
    Unit cur, nxt; int ui = 0;
    if (!S.next(0, cur)) return;
    f32x4 acc[2][2][4][2];
#pragma unroll
    for (int a = 0; a < 2; ++a)
#pragma unroll
        for (int b = 0; b < 2; ++b)
#pragma unroll
            for (int m = 0; m < 4; ++m)
#pragma unroll
                for (int n = 0; n < 2; ++n) acc[a][b][m][n] = (f32x4){0.f, 0.f, 0.f, 0.f};
    bf16x8 At[4][2], B0[2][2], B1[2][2];
    const char* cA = (const char*)g.A + (long)cur.arow * rowb; const char* cB = (const char*)g.Bt + (size_t)cur.pn * tstepB;
    PG8_STAGE(PG8_SB(0, 0), cB, voffB); PG8_STAGE(PG8_SB(0, 1), cB + hstepB, voffB); PG8_STAGE(PG8_SA(0, 0), cA, voffA); PG8_STAGE(PG8_SA(0, 1), cA + hstepA, voffA);
    if (wr == 1) PG8_BAR;
    PG8_WAIT_V(2); PG8_BAR;
    PG8_STAGE(PG8_SB(1, 0), cB + kstep, voffB); PG8_STAGE(PG8_SA(1, 0), cA + kstep, voffA); PG8_STAGE(PG8_SB(1, 1), cB + hstepB + kstep, voffB);
    PG8_WAIT_V(6); PG8_BAR;
    for (;;) {
        const bool has_next = S.next(ui + 1, nxt);
        const char* nA = has_next ? (const char*)g.A + (long)nxt.arow * rowb : cA; const char* nB = has_next ? (const char*)g.Bt + (size_t)nxt.pn * tstepB : cB;
        for (int t = 0; t < nt; t += 2) {
            const bool last = (t == nt - 2);
            const char* a1 = cA + (size_t)(t + 1) * kstep;
            const char* a2 = last ? nA : cA + (size_t)(t + 2) * kstep; const char* b2 = last ? nB : cB + (size_t)(t + 2) * kstep;
            const char* a3 = a2 + kstep; const char* b3 = b2 + kstep;
            PG8_LDB(B0, 0, 0); PG8_LDB(B1, 0, 1); PG8_SCHED; PG8_LDA(At, 0, 0); PG8_STAGE(PG8_SA(1, 1), a1 + hstepA, voffA);
            PG8_WAIT_V(8); PG8_WAIT_L(0); PG8_BAR; PG8_MMA(0, 0, At, B0); PG8_MMA(0, 1, At, B1); PG8_BAR; PG8_SCHED;
            PG8_LDA(At, 0, 1); PG8_STAGE(PG8_SB(0, 0), b2, voffB); PG8_STAGE(PG8_SB(0, 1), b2 + hstepB, voffB); PG8_STAGE(PG8_SA(0, 0), a2, voffA);
            PG8_WAIT_V(8); PG8_WAIT_L(0); PG8_BAR; PG8_MMA(1, 0, At, B0); PG8_MMA(1, 1, At, B1); PG8_BAR; PG8_SCHED;
            PG8_LDB(B0, 1, 0); PG8_LDB(B1, 1, 1); PG8_SCHED; PG8_LDA(At, 1, 0); PG8_STAGE(PG8_SA(0, 1), a2 + hstepA, voffA);
            PG8_WAIT_V(8); PG8_WAIT_L(0); PG8_BAR; PG8_MMA(0, 0, At, B0); PG8_MMA(0, 1, At, B1); PG8_BAR; PG8_SCHED;
            PG8_LDA(At, 1, 1); PG8_STAGE(PG8_SB(1, 0), b3, voffB); PG8_STAGE(PG8_SB(1, 1), b3 + hstepB, voffB); PG8_STAGE(PG8_SA(1, 0), a3, voffA);
            PG8_WAIT_V(8); PG8_WAIT_L(0); PG8_BAR; PG8_MMA(1, 0, At, B0); PG8_MMA(1, 1, At, B1); PG8_BAR; PG8_SCHED;
        }
        if constexpr (ALIGN_EPI) { if (wr == 0) PG8_BAR; }
        if constexpr (!Epi::AFTER_DRAIN) { E(acc, cur, wr, wc, fr, fq); }
        if (!has_next) break;
#pragma unroll
        for (int a = 0; a < 2; ++a)
#pragma unroll
            for (int b = 0; b < 2; ++b)
#pragma unroll
                for (int m = 0; m < 4; ++m)
#pragma unroll
                    for (int n = 0; n < 2; ++n) acc[a][b][m][n] = (f32x4){0.f, 0.f, 0.f, 0.f};
        cur = nxt; cA = nA; cB = nB; ++ui;
        if constexpr (ALIGN_EPI) { if (wr == 1) PG8_BAR; }
    }
    PG8_WAIT_V(0);
    if constexpr (!ALIGN_EPI) { if (wr == 0) PG8_BAR; }
    PG8_BAR;
    if constexpr (Epi::AFTER_DRAIN) { E.fused(acc, cur, wr, wc, fr, fq, lds, wid, lane); }
#undef PG8_SA
#undef PG8_SB
#undef PG8_STAGE
#undef PG8_LDA
#undef PG8_LDB
#undef PG8_MMA
#undef PG8_WAIT_V
#undef PG8_WAIT_L
#undef PG8_BAR
#undef PG8_SCHED
}
}

struct Args {
    const float* x; const float* attn_norm_w; const float* w_in; const float* sink; const float* mix_w; const float* mix_b; const float* aon_w; const float* con_w;
    const float* w_out; const float* ffn_norm_w; const float* w_gate; const float* w_up; const float* ffn_cw; const float* ffn_cb; const float* w_down; const float* final_w;
    float* out; unsigned char* ws;
    int cg_seam; int pad;
};

__device__ __forceinline__ float wave_sum(float v) {
#pragma unroll
    for (int o = 1; o < 64; o <<= 1) v += __shfl_xor(v, o);
    return v;
}

__device__ __forceinline__ void p0_transpose_item(const float* __restrict__ W, int N, const float* __restrict__ fold, bf16_t* WT, int ldt, int k0, int n0, int drow0, LAS unsigned* scr, int lane) {
    const int nq = lane & 15, kg = lane >> 4;
    f32x4 va[8], vb[8]; f32x2 fv[8];
#pragma unroll
    for (int s = 0; s < 8; ++s) { const float* p = W + (size_t)(k0 + 2 * (kg + 4 * s)) * N + n0 + 4 * nq; va[s] = __builtin_nontemporal_load((const f32x4*)p); vb[s] = __builtin_nontemporal_load((const f32x4*)(p + N));
        fv[s] = fold ? *(const f32x2*)(fold + k0 + 2 * (kg + 4 * s)) : (f32x2){1.f, 1.f}; }
#pragma unroll
    for (int s = 0; s < 8; ++s) { const int kp = kg + 4 * s; const float f0 = fv[s][0], f1 = fv[s][1];
        LAS unsigned* d = scr + kp * 65 + 4 * nq;
        d[0] = cvt_pk_bf16(va[s][0] * f0, vb[s][0] * f1); d[1] = cvt_pk_bf16(va[s][1] * f0, vb[s][1] * f1); d[2] = cvt_pk_bf16(va[s][2] * f0, vb[s][2] * f1); d[3] = cvt_pk_bf16(va[s][3] * f0, vb[s][3] * f1); }
    LDS_WAIT();
    const int c = lane & 7;
#pragma unroll
    for (int j = 0; j < 8; ++j) { const int n = (lane >> 3) + 8 * j; const LAS unsigned* s = scr + (4 * c) * 65 + n;
        u32x4 o; o.x = s[0]; o.y = s[65]; o.z = s[130]; o.w = s[195];
        *(u32x4*)(WT + (size_t)(drow0 + n) * ldt + k0 + 8 * c) = o; }
    LDS_WAIT();
}
__device__ __forceinline__ void p0_convert(const Args& a, LAS unsigned char* lds, int lane, int wave, int it_lo, int it_hi, int widx, int nworkers) {
    lane = opaque_v(lane);
    LAS unsigned* scr = (LAS unsigned*)(lds + wave * 8320);
    bf16_t* Win_t = (bf16_t*)(a.ws + WS_WIN); bf16_t* Wout_t = (bf16_t*)(a.ws + WS_WOUT); bf16_t* Wgu_t = (bf16_t*)(a.ws + WS_WGU); bf16_t* Wd_t = (bf16_t*)(a.ws + WS_WD);
    constexpr int I_IN = 32 * 72, I_OUT = 32 * 32, I_G = 32 * 88;
    for (int it = it_lo + widx; it < it_hi; it += nworkers) {
        int r = it, kb, nb, N, ldt, drow0; const float* W; const float* fold; bf16_t* WT;
        if (r < I_IN) { kb = r / 72; nb = r % 72; W = a.w_in; N = INW; fold = a.attn_norm_w; WT = Win_t; ldt = DM; drow0 = 64 * nb; }
        else if ((r -= I_IN) < I_OUT) { kb = r / 32; nb = r % 32; W = a.w_out; N = DM; fold = kb < 16 ? a.aon_w : a.con_w - 1024; WT = Wout_t; ldt = DM; drow0 = 64 * nb; }
        else if ((r -= I_OUT) < I_G) { kb = r / 88; nb = r % 88; W = a.w_gate; N = FF; fold = a.ffn_norm_w; WT = Wgu_t; ldt = DM; drow0 = ((64 * nb) >> 7) * 256 + ((64 * nb) & 127); }
        else if ((r -= I_G) < I_G) { kb = r / 88; nb = r % 88; W = a.w_up; N = FF; fold = a.ffn_norm_w; WT = Wgu_t; ldt = DM; drow0 = ((64 * nb) >> 7) * 256 + 128 + ((64 * nb) & 127); }
        else { r -= I_G; kb = r / 32; nb = r % 32; W = a.w_down; N = DM; fold = nullptr; WT = Wd_t; ldt = FF; drow0 = 64 * nb; }
        p0_transpose_item(W, N, fold, WT, ldt, 64 * kb, 64 * nb, drow0, scr, lane);
    }
}
constexpr int P0_ITEMS_EARLY = 32 * 72 + 32 * 32, P0_ITEMS_GU = 32 * 72 + 32 * 32 + 2 * 32 * 88, P0_ITEMS_ALL = P0_ITEMS_GU + 88 * 32, P0_ITEMS_SPLIT = P0_ITEMS_GU + 936;
__device__ __forceinline__ void p0_prologue(const Args& a, LAS unsigned char* lds, int lane, int wave) {
    const int gw = blockIdx.x * 8 + wave, NGW = gridDim.x * 8;
    p0_convert(a, lds, lane, wave, 0, P0_ITEMS_EARLY, gw, NGW);
    lane = opaque_v(lane);
    bf16_t* H = (bf16_t*)(a.ws + WS_H);
    int row_lo, row_n;
    { const int n2 = P0_ITEMS_EARLY - NGW;
      if (NGW == 2048 && n2 == 1280) { if (gw < n2) { row_lo = 3 * gw; row_n = 3; } else { row_lo = 3 * n2 + 5 * (gw - n2); row_n = 5; } }
      else { row_lo = gw * (MTOK / NGW); row_n = MTOK / NGW; } }
    for (int mi = 0; mi < row_n + 1; ++mi) {
        int m = row_lo + mi;
        if (mi == row_n) { if (NGW == 2048 && P0_ITEMS_EARLY - NGW == 1280 && gw < 512) m = 7680 + gw; else break; }
        const f32x4* xr = (const f32x4*)(a.x + (size_t)m * DM) + lane; f32x4 v[8]; float s = 0.f;
#pragma unroll
        for (int j = 0; j < 8; ++j) { v[j] = __builtin_nontemporal_load(xr + 64 * j); s += (v[j][0] * v[j][0] + v[j][1] * v[j][1]) + (v[j][2] * v[j][2] + v[j][3] * v[j][3]); }
        const float rn = 1.0f / sqrtf(wave_sum(s) * (1.0f / DM) + EPS);
        if (lane == 0) ((float*)(a.ws + WS_SSQ) + (size_t)MTOK * 17)[m] = rn;
        u32x2* o8 = (u32x2*)(H + (size_t)m * DM) + lane;
#pragma unroll
        for (int j = 0; j < 8; ++j) { u32x2 o; o.x = cvt_pk_bf16(v[j][0], v[j][1]); o.y = cvt_pk_bf16(v[j][2], v[j][3]); o8[64 * j] = o; }
    }
}

__device__ __forceinline__ s16x4 tr16(const LAS unsigned char* p) { return __builtin_bit_cast(s16x4, __builtin_amdgcn_ds_read_tr16_b64_v4i16((LAS s16x4*)p)); }
__device__ __forceinline__ void p2_attn_conv(const Args& a, LAS unsigned char* lds, int tid, int lane, int wid) {
    tid = opaque_v(tid); lane = tid & 63;
    constexpr int RS = 1040, KVB = 32 * RS, NBUF = 4;
    const bf16_t* PROJ = (const bf16_t*)(a.ws + WS_PROJ); bf16_t* MIXED = (bf16_t*)(a.ws + WS_MIX);
    LAS float* red = (LAS float*)(lds + NBUF * KVB);
    LAS float* red2 = red + 256;
#define P2_WAITV(n) asm volatile("s_waitcnt vmcnt(" #n ")" ::: "memory")
    const int vcu = (gridDim.x % 8 == 0) ? (int)((blockIdx.x % 8) * (gridDim.x / 8) + blockIdx.x / 8) : (int)blockIdx.x;
    for (int item = vcu; item < MTOK / 32; item += gridDim.x) {
        tid = opaque_v(tid); lane = tid & 63;
        const int r32 = lane & 31, h = lane >> 5;
        const int b = item >> 7, t0 = (item & 127) * 32; const size_t rowbase = (size_t)b * SEQ;
        int jlo = 4 - (t0 >> 5); if (jlo < 0) jlo = 0;
        int jhi = (SEQ + 128 - t0) >> 5; if (jhi > 9) jhi = 9;
#define P2_DMA(j) do { const bf16_t* src_ = PROJ + (rowbase + (t0 - 128 + 32 * (j)) + wid) * INW + COL_K + lane * 8; LAS unsigned char* dst_ = lds + ((j) & 3) * KVB + wid * RS; \
            _Pragma("unroll") for (int i_ = 0; i_ < 4; ++i_) __builtin_amdgcn_global_load_lds((const unsigned*)(src_ + (size_t)(8 * i_) * INW), (LAS unsigned*)(dst_ + (8 * i_) * RS), 16, 0, 0); } while (0)
        P2_DMA(jlo); P2_DMA(jlo + 1); P2_DMA(jlo + 2);
        {
            const int c0 = (tid & 127) * 8, tg = tid >> 7, tb = t0 + 8 * tg;
            float w0[8], w1[8], w2[8], bb[8];
#pragma unroll
            for (int hh = 0; hh < 2; ++hh) { const f32x4 a0 = *(const f32x4*)(a.mix_w + c0 + 4 * hh), a1 = *(const f32x4*)(a.mix_w + 1024 + c0 + 4 * hh), a2 = *(const f32x4*)(a.mix_w + 2048 + c0 + 4 * hh), a3 = *(const f32x4*)(a.mix_b + c0 + 4 * hh);
#pragma unroll
                for (int e = 0; e < 4; ++e) { w0[4 * hh + e] = a0[e]; w1[4 * hh + e] = a1[e]; w2[4 * hh + e] = a2[e]; bb[4 * hh + e] = a3[e]; } }
            float res[8][8], sq[8];
#pragma unroll
            for (int rd = 0; rd < 2; ++rd) {
                const int tr = tb + 4 * rd;
                u32x4 cv[6], uv[6], bv[4];
#pragma unroll
                for (int tt = 0; tt < 6; ++tt) { const int t = tr - 1 + tt, tc = t < 0 ? 0 : (t > SEQ - 1 ? SEQ - 1 : t); const bf16_t* rp = PROJ + (rowbase + tc) * INW + c0; cv[tt] = __builtin_nontemporal_load((const u32x4*)(rp + COL_C)); uv[tt] = __builtin_nontemporal_load((const u32x4*)(rp + COL_U)); }
#pragma unroll
                for (int i = 0; i < 4; ++i) bv[i] = __builtin_nontemporal_load((const u32x4*)(PROJ + (rowbase + tr + i) * INW + COL_B + c0));
                float cp[8], cc[8], cn[8];
#define P2_CU(dst, tt) do { const int t_ = tr - 1 + (tt); const float ok_ = (t_ >= 0 && t_ < SEQ) ? 1.f : 0.f; \
                _Pragma("unroll") for (int e = 0; e < 4; ++e) { dst[2 * e] = bf_lo(cv[tt][e]) * bf_lo(uv[tt][e]) * ok_; dst[2 * e + 1] = bf_hi(cv[tt][e]) * bf_hi(uv[tt][e]) * ok_; } } while (0)
                P2_CU(cp, 0); P2_CU(cc, 1);
#pragma unroll
                for (int i = 0; i < 4; ++i) {
                    P2_CU(cn, i + 2);
                    float s = 0.f;
#pragma unroll
                    for (int e = 0; e < 8; ++e) { const float bg = (e & 1) ? bf_hi(bv[i][e >> 1]) : bf_lo(bv[i][e >> 1]); const float rv = bg * (w0[e] * cp[e] + w1[e] * cc[e] + w2[e] * cn[e] + bb[e]); res[4 * rd + i][e] = rv; s += rv * rv; }
                    sq[4 * rd + i] = s;
#pragma unroll
                    for (int e = 0; e < 8; ++e) { cp[e] = cc[e]; cc[e] = cn[e]; }
                }
#undef P2_CU
            }
#pragma unroll
            for (int i = 0; i < 8; ++i) sq[i] = wave_sum(sq[i]);
            if (lane == 0) {
#pragma unroll
                for (int i = 0; i < 8; ++i) red2[wid * 8 + i] = sq[i]; }
            __syncthreads();
#pragma unroll
            for (int i = 0; i < 8; ++i) { const float tot = red2[(2 * tg) * 8 + i] + red2[(2 * tg + 1) * 8 + i]; const float rn = 1.0f / sqrtf(tot * (1.0f / 1024.0f) + EPS);
                u32x4 w; w.x = cvt_pk_bf16(res[i][0] * rn, res[i][1] * rn); w.y = cvt_pk_bf16(res[i][2] * rn, res[i][3] * rn); w.z = cvt_pk_bf16(res[i][4] * rn, res[i][5] * rn); w.w = cvt_pk_bf16(res[i][6] * rn, res[i][7] * rn);
                *(u32x4*)(MIXED + (rowbase + tb + i) * DM + 1024 + c0) = w; }
        }
        {
            const int hd = wid, kvh = wid >> 2;
            bf16x8 qf[8];
            { const bf16_t* qp = PROJ + (rowbase + t0 + r32) * INW + hd * 128 + h * 8;
#pragma unroll
              for (int st = 0; st < 8; ++st) qf[st] = __builtin_nontemporal_load((const bf16x8*)(qp + st * 16)); }
            f32x16 o[4];
#pragma unroll
            for (int d = 0; d < 4; ++d)
#pragma unroll
                for (int r = 0; r < 16; ++r) o[d][r] = 0.f;
            float m_run = a.sink[hd] * LOG2E, l_run = (h == 0) ? 1.f : 0.f;
            const float slope2 = exp2f(-(float)(hd + 1)) * LOG2E, c2 = 0.08838834764831845f * LOG2E;
            const int g1 = (lane >> 4) & 1, q4 = (lane & 15) >> 2, p4 = lane & 3;
            P2_WAITV(0);
#pragma unroll
            for (int st = 0; st < 8; ++st) asm volatile("" : "+v"(qf[st]));
            for (int j = jlo; j < jhi; ++j) {
                const int rem = jhi - 1 - j;
                if (rem >= 2) P2_WAITV(8); else if (rem == 1) P2_WAITV(4); else P2_WAITV(0);
                asm volatile("s_waitcnt lgkmcnt(0)" ::: "memory");
                __builtin_amdgcn_s_barrier();
                asm volatile("" ::: "memory");
                if (j + 3 < jhi) P2_DMA(j + 3);
                const LAS unsigned char* kb = lds + (j & 3) * KVB;
                f32x16 s;
#pragma unroll
                for (int r = 0; r < 16; ++r) s[r] = 0.f;
#pragma unroll
                for (int st = 0; st < 8; ++st) { const bf16x8 kf = *(const LAS bf16x8*)(kb + r32 * RS + kvh * 256 + st * 32 + h * 16); s = __builtin_amdgcn_mfma_f32_32x32x16_bf16(kf, qf[st], s, 0, 0, 0); }
                const float basef = (float)(32 * j - 128 + 4 * h - r32);
                float tmax = -1e30f;
                if (j == 0 || j == 8) {
#pragma unroll
                    for (int r = 0; r < 16; ++r) { const float af = fabsf(basef + (float)((r & 3) + 8 * (r >> 2))); float v = s[r] * c2 - slope2 * af; v = (af <= 128.f) ? v : -1e30f; s[r] = v; tmax = fmaxf(tmax, v); }
                } else {
#pragma unroll
                    for (int r = 0; r < 16; ++r) { const float af = fabsf(basef + (float)((r & 3) + 8 * (r >> 2))); const float v = s[r] * c2 - slope2 * af; s[r] = v; tmax = fmaxf(tmax, v); }
                }
                tmax = fmaxf(tmax, __shfl_xor(tmax, 32));
                if (__builtin_amdgcn_ballot_w64(tmax > m_run + 6.0f) != 0ull) {
                    const float m_new = fmaxf(m_run, tmax), alpha = __builtin_amdgcn_exp2f(m_run - m_new); m_run = m_new;
                    l_run *= alpha;
#pragma unroll
                    for (int d = 0; d < 4; ++d)
#pragma unroll
                        for (int r = 0; r < 16; ++r) o[d][r] *= alpha;
                }
                float psum = 0.f;
#pragma unroll
                for (int r = 0; r < 16; ++r) { const float p = __builtin_amdgcn_exp2f(s[r] - m_run); s[r] = p; psum += p; }
                l_run += psum;
                u32x4 pw0, pw1;
                pw0.x = cvt_pk_bf16(s[0], s[1]); pw0.y = cvt_pk_bf16(s[2], s[3]); pw0.z = cvt_pk_bf16(s[4], s[5]); pw0.w = cvt_pk_bf16(s[6], s[7]);
                pw1.x = cvt_pk_bf16(s[8], s[9]); pw1.y = cvt_pk_bf16(s[10], s[11]); pw1.z = cvt_pk_bf16(s[12], s[13]); pw1.w = cvt_pk_bf16(s[14], s[15]);
                const bf16x8 pf0 = __builtin_bit_cast(bf16x8, pw0), pf1 = __builtin_bit_cast(bf16x8, pw1);
                const unsigned vba = (unsigned)(size_t)(kb + (4 * h + q4) * RS + 512 + kvh * 256 + g1 * 32 + p4 * 8);
                s16x4 vlo[8], vhi[8];
#pragma unroll
                for (int d = 0; d < 4; ++d)
#pragma unroll
                    for (int ks = 0; ks < 2; ++ks) {
                        asm volatile("ds_read_b64_tr_b16 %0, %1 offset:%c2" : "=&v"(vlo[2 * d + ks]) : "v"(vba), "i"((16 * ks) * RS + d * 64) : "memory");
                        asm volatile("ds_read_b64_tr_b16 %0, %1 offset:%c2" : "=&v"(vhi[2 * d + ks]) : "v"(vba), "i"((16 * ks + 8) * RS + d * 64) : "memory"); }
                asm volatile("s_waitcnt lgkmcnt(0)" : "+v"(vlo[0]), "+v"(vlo[1]), "+v"(vlo[2]), "+v"(vlo[3]), "+v"(vlo[4]), "+v"(vlo[5]), "+v"(vlo[6]), "+v"(vlo[7]) :: "memory");
                asm volatile("" : "+v"(vhi[0]), "+v"(vhi[1]), "+v"(vhi[2]), "+v"(vhi[3]), "+v"(vhi[4]), "+v"(vhi[5]), "+v"(vhi[6]), "+v"(vhi[7]) :: "memory");
                __builtin_amdgcn_sched_barrier(0);
#pragma unroll
                for (int d = 0; d < 4; ++d)
#pragma unroll
                    for (int ks = 0; ks < 2; ++ks) { const s16x4 lo = vlo[2 * d + ks], hi = vhi[2 * d + ks];
                        const bf16x8 vf = (bf16x8){lo[0], lo[1], lo[2], lo[3], hi[0], hi[1], hi[2], hi[3]};
                        o[d] = __builtin_amdgcn_mfma_f32_32x32x16_bf16(vf, ks ? pf1 : pf0, o[d], 0, 0, 0); }
            }
            const float l_tot = l_run + __shfl_xor(l_run, 32), inv = 1.0f / l_tot;
            float ssq = 0.f;
#pragma unroll
            for (int d = 0; d < 4; ++d)
#pragma unroll
                for (int r = 0; r < 16; ++r) { o[d][r] *= inv; ssq += o[d][r] * o[d][r]; }
            ssq += __shfl_xor(ssq, 32);
            if (h == 0) red[wid * 32 + r32] = ssq;
            __syncthreads();
            float tot = 0.f;
#pragma unroll
            for (int w = 0; w < 8; ++w) tot += red[w * 32 + r32];
            const float rn = 1.0f / sqrtf(tot * (1.0f / 1024.0f) + EPS);
            bf16_t* op = MIXED + (rowbase + t0 + r32) * DM + hd * 128 + 4 * h;
#pragma unroll
            for (int d = 0; d < 4; ++d)
#pragma unroll
                for (int gq = 0; gq < 4; ++gq) { u32x2 w; w.x = cvt_pk_bf16(o[d][4 * gq] * rn, o[d][4 * gq + 1] * rn); w.y = cvt_pk_bf16(o[d][4 * gq + 2] * rn, o[d][4 * gq + 3] * rn);
                    *(u32x2*)(op + d * 32 + 8 * gq) = w; }
        }
#undef P2_DMA
        __syncthreads();
    }
#undef P2_WAITV
}

__device__ __forceinline__ void p6_final(const Args& a, int lane, int wave) {
    lane = opaque_v(lane);
    const int gw = blockIdx.x * 8 + wave, NGW = gridDim.x * 8;
    for (int m = gw; m < MTOK; m += NGW) {
        f32x4* xr = (f32x4*)(a.out + (size_t)m * DM) + lane; f32x4 v[8]; float s = 0.f;
#pragma unroll
        for (int j = 0; j < 8; ++j) { v[j] = xr[64 * j]; s += (v[j][0] * v[j][0] + v[j][1] * v[j][1]) + (v[j][2] * v[j][2] + v[j][3] * v[j][3]); }
        const float rn = 1.0f / sqrtf(wave_sum(s) * (1.0f / DM) + EPS);
#pragma unroll
        for (int j = 0; j < 8; ++j) { const f32x4 w = ((const f32x4*)a.final_w)[lane + 64 * j]; xr[64 * j] = v[j] * rn * w; }
    }
}

#define XB_TMO      128
#define XB_XCNT(j)  (256  + 64 * (j))
#define XB_XSUB(j)  (1280 + 64 * (j))
#define XB_XGEN(j)  (2304 + 64 * (j))
#define XB_TOP      3328
#define XB_TOPGEN   3392
#define XCD_BAR_WORDS 3456
#define XB_SPIN_CAP (1u << 18)
__device__ __forceinline__ unsigned xb_ld(unsigned* p)              { return __hip_atomic_load(p, __ATOMIC_RELAXED, __HIP_MEMORY_SCOPE_AGENT); }
__device__ __forceinline__ unsigned xb_add(unsigned* p, unsigned v) { return __hip_atomic_fetch_add(p, v, __ATOMIC_RELAXED, __HIP_MEMORY_SCOPE_AGENT); }
__device__ __forceinline__ unsigned xb_xcc_id() { return (unsigned)__builtin_amdgcn_s_getreg((3 << 11) | 20) & 0xFu; }
#define XB_SPIN(cond, bar) do { unsigned _sp = 0; while (cond) { __builtin_amdgcn_s_sleep(1); \
    if ((++_sp & 255u) == 0u) { if (xb_ld(&(bar)[XB_TMO])) break; if (_sp > XB_SPIN_CAP) { atomicAdd(&(bar)[XB_TMO], 1u); break; } } } } while (0)
struct XcdBarrier { unsigned* bar; unsigned x; volatile LAS unsigned* st; };
__device__ __forceinline__ XcdBarrier xcd_barrier_post(unsigned* bar, volatile LAS unsigned* st) {
    XcdBarrier b; b.bar = bar; b.x = xb_xcc_id(); b.st = st;
    if (threadIdx.x == 0) (void)xb_add(&bar[XB_XCNT(b.x)], 1u);
    return b;
}
__device__ __forceinline__ void xcd_barrier_complete(unsigned* bar, unsigned x, unsigned& nloc, unsigned& nx) {
    const unsigned G = gridDim.x * gridDim.y * gridDim.z;
    unsigned sum, cnt, mine, sp = 0u;
    for (;;) {
        sum = 0u; cnt = 0u; mine = 0u;
#pragma unroll
        for (unsigned j = 0; j < 16; ++j) { const unsigned c = xb_ld(&bar[XB_XCNT(j)]); sum += c; cnt += (c > 0u) ? 1u : 0u; mine = (j == x) ? c : mine; }
        if (sum == G) break;
        __builtin_amdgcn_s_sleep(1);
        if ((++sp & 255u) == 0u) { if (xb_ld(&bar[XB_TMO])) break; if (sp > XB_SPIN_CAP) { atomicAdd(&bar[XB_TMO], 1u); break; } }
    }
    nloc = mine > 0u ? mine : 1u; nx = cnt > 0u ? cnt : 1u;
}
__device__ __forceinline__ void xcd_barrier(const XcdBarrier& b) {
    asm volatile("s_waitcnt vmcnt(0)" ::: "memory");
    __syncthreads();
    if (threadIdx.x == 0) {
        unsigned* bar = b.bar;
        __builtin_amdgcn_s_waitcnt(0);
        unsigned nloc = b.st[0], nx = b.st[1];
        if (nloc == 0u) { xcd_barrier_complete(bar, b.x, nloc, nx); b.st[0] = nloc; b.st[1] = nx; }
        const unsigned old = xb_add(&bar[XB_XSUB(b.x)], 1u);
        const unsigned gen = old / nloc;
        if (old + 1u == (gen + 1u) * nloc) {
            __builtin_amdgcn_fence(__ATOMIC_RELEASE, "agent");
            asm volatile("s_waitcnt vmcnt(0)" ::: "memory");
            const unsigned og = xb_add(&bar[XB_TOP], 1u);
            const unsigned tg = og / nx;
            if (og + 1u == (tg + 1u) * nx) xb_add(&bar[XB_TOPGEN], 1u);
            else XB_SPIN(xb_ld(&bar[XB_TOPGEN]) == tg, bar);
            __builtin_amdgcn_fence(__ATOMIC_ACQUIRE, "agent");
            xb_add(&bar[XB_XGEN(b.x)], 1u);
            asm volatile("s_waitcnt vmcnt(0)" ::: "memory");
        } else {
            XB_SPIN(xb_ld(&bar[XB_XGEN(b.x)]) == gen, bar);
            __builtin_amdgcn_fence(__ATOMIC_ACQUIRE, "agent");
            asm volatile("s_waitcnt vmcnt(0)" ::: "memory");
        }
    }
    __syncthreads();
}

__global__ void __launch_bounds__(NTHR, 2) fwd_megakernel(Args a) {
    extern __shared__ __attribute__((aligned(16))) unsigned char lds_raw[];
    LAS unsigned char* lds = (LAS unsigned char*)lds_raw;
    cg::grid_group grid = cg::this_grid();
    const int tid = threadIdx.x, lane = tid & 63, wave = __builtin_amdgcn_readfirstlane(tid >> 6);
    const int G = gridDim.x, c = blockIdx.x;
    volatile LAS unsigned* xst = (volatile LAS unsigned*)(lds + LDS_BYTES - 64);
    if (tid < 2) xst[tid] = 0u;
    __syncthreads();
    const XcdBarrier xbar = xcd_barrier_post((unsigned*)(a.ws + WS_CTL), xst);
#define SEAM() xcd_barrier(xbar)
    bf16_t* H = (bf16_t*)(a.ws + WS_H); bf16_t* PROJ = (bf16_t*)(a.ws + WS_PROJ); bf16_t* X1B = (bf16_t*)(a.ws + WS_X1B) + DM; bf16_t* ACT = (bf16_t*)(a.ws + WS_ACT); float* SSQ = (float*)(a.ws + WS_SSQ);
    const bf16_t* Win_t = (const bf16_t*)(a.ws + WS_WIN); const bf16_t* Wout_t = (const bf16_t*)(a.ws + WS_WOUT); const bf16_t* Wgu_t = (const bf16_t*)(a.ws + WS_WGU); const bf16_t* Wd_t = (const bf16_t*)(a.ws + WS_WD);

#ifndef PROBE_DUP
#define PROBE_DUP -1
#endif
#define NREP(k) ((PROBE_DUP == (k)) ? 2 : 1)
    for (int rep = 0; rep < NREP(0); ++rep) {
    p0_prologue(a, lds, lane, wave);
    if (a.cg_seam) grid.sync(); else SEAM();
    }
    if (PROBE_DUP == 7) { for (int rep = 0; rep < 10; ++rep) SEAM(); }
    for (int rep = 0; rep < NREP(1); ++rep)
    {
        pg8::Gemm g{H, Win_t, DM}; pg8::Order S; S.init(MTOK / 256, INW / 256, G, c, G == 256 ? 2 : 0);
        pg8::EpiBf16 E{PROJ, INW, SSQ + (size_t)MTOK * 17};
        pg8::gemm_phase<pg8::EpiBf16, false, true>(lds, g, S, E);
        if (G == 256) { if ((c & 7) >= 2) p0_convert(a, lds, lane, wave, P0_ITEMS_EARLY, P0_ITEMS_SPLIT, ((c >> 3) * 6 + (c & 7) - 2) * 8 + wave, 192 * 8); }
        else p0_convert(a, lds, lane, wave, P0_ITEMS_EARLY, P0_ITEMS_SPLIT, c * 8 + wave, G * 8);
        SEAM();
    }
    for (int rep = 0; rep < NREP(2); ++rep) {
    p2_attn_conv(a, lds, tid, lane, wave);
    SEAM();
    }
    for (int rep = 0; rep < NREP(3); ++rep)
    {
        pg8::Gemm g{(const bf16_t*)(a.ws + WS_MIX), Wout_t, DM}; pg8::Order S; S.init(MTOK / 256, DM / 256, G, c, 0);
        pg8::EpiRes1 E{H  , X1B, SSQ, (unsigned*)(a.ws + WS_CTL) + 6144, SSQ + (size_t)MTOK * 16};
        pg8::gemm_phase<pg8::EpiRes1, false, false>(lds, g, S, E);
        SEAM();
    }
    for (int rep = 0; rep < NREP(4); ++rep)
    {
        pg8::Gemm g{X1B, Wgu_t, DM}; pg8::Order S; S.init(34, 2 * FF / 256, G, c, 1);
        pg8::EpiFfn E{ACT, SSQ + (size_t)MTOK * 16, a.ffn_cw, a.ffn_cb};
        pg8::gemm_phase<pg8::EpiFfn, true, true>(lds, g, S, E);
        if (rep == 0) { const int nu = 34 * (2 * FF / 256), r = nu % G;
          const int wbase = r ? (c - r) : c, nw = r ? (G - r) : G;
          if (wbase >= 0) p0_convert(a, lds, lane, wave, P0_ITEMS_SPLIT, P0_ITEMS_ALL, wbase * 8 + wave, nw * 8); }
        SEAM();
    }
    {
        pg8::Gemm g{ACT, Wd_t, FF}; pg8::Order S; S.init(MTOK / 256, DM / 256, G, c, 0);
        pg8::EpiFinal E{X1B, a.out, SSQ + (size_t)MTOK * 8, (unsigned*)(a.ws + WS_CTL) + 4096, a.final_w};
        pg8::gemm_phase<pg8::EpiFinal, false, false>(lds, g, S, E);
    }
}

extern "C" void kernel_launch(void* const* d_in, const int* in_sizes, int n_in, void* d_out, int out_size, void* d_ws, size_t ws_size, hipStream_t stream) {
    static int grid = 0;
    if (grid == 0) {
        if (n_in != 16 || out_size != MTOK * DM || ws_size < WS_END) { fprintf(stderr, "kernel_launch: unexpected shapes (n_in %d, out %d, ws %zu)\n", n_in, out_size, ws_size); grid = -1; return; }
        int dev = 0, cus = 0, per_cu = 0;
        hipGetDevice(&dev); hipDeviceGetAttribute(&cus, hipDeviceAttributeMultiprocessorCount, dev);
        hipFuncSetAttribute((const void*)fwd_megakernel, hipFuncAttributeMaxDynamicSharedMemorySize, LDS_BYTES);
        hipOccupancyMaxActiveBlocksPerMultiprocessor(&per_cu, (const void*)fwd_megakernel, NTHR, LDS_BYTES);
        grid = cus * per_cu;
        if (grid != 256) { fprintf(stderr, "kernel_launch: resident capacity %d x %d; this kernel needs exactly 256 workgroups\n", cus, per_cu); if (grid > 256) grid = 256; else { grid = -1; return; } }
    }
    if (grid < 0) return;
    if (hipMemsetAsync((char*)d_ws + WS_CTL, 0, CTL_BYTES, stream) != hipSuccess) { fprintf(stderr, "kernel_launch: memset of the barrier words failed\n"); return; }
    Args a{};
    a.x = (const float*)d_in[0]; a.attn_norm_w = (const float*)d_in[1]; a.w_in = (const float*)d_in[2]; a.sink = (const float*)d_in[3]; a.mix_w = (const float*)d_in[4]; a.mix_b = (const float*)d_in[5];
    a.aon_w = (const float*)d_in[6]; a.con_w = (const float*)d_in[7]; a.w_out = (const float*)d_in[8]; a.ffn_norm_w = (const float*)d_in[9]; a.w_gate = (const float*)d_in[10]; a.w_up = (const float*)d_in[11];
    a.ffn_cw = (const float*)d_in[12]; a.ffn_cb = (const float*)d_in[13]; a.w_down = (const float*)d_in[14]; a.final_w = (const float*)d_in[15];
    a.out = (float*)d_out; a.ws = (unsigned char*)d_ws;
    void* args[] = {&a};
    hipError_t e = hipLaunchCooperativeKernel((const void*)fwd_megakernel, dim3(grid), dim3(NTHR), args, LDS_BYTES, stream);
    if (e != hipSuccess) fprintf(stderr, "cooperative launch failed: %s (grid %d)\n", hipGetErrorString(e), grid);
}
```

```cpp
#include <hip/hip_runtime.h>
#include <hip/hip_cooperative_groups.h>
#include <cstdio>
#include <cstdint>
namespace cg = cooperative_groups;

#define LAS __attribute__((address_space(3)))
typedef unsigned short bf16_t;
typedef short bf16x8 __attribute__((ext_vector_type(8)));
typedef short s16x4 __attribute__((ext_vector_type(4)));
typedef float f32x4 __attribute__((ext_vector_type(4)));
typedef float f32x2 __attribute__((ext_vector_type(2)));
typedef float f32x16 __attribute__((ext_vector_type(16)));
typedef unsigned u32x4 __attribute__((ext_vector_type(4)));
typedef unsigned u32x2 __attribute__((ext_vector_type(2)));

constexpr int SEQ = 4096, MTOK = 8192, DM = 2048, INW = 4608, FF = 5632;
constexpr int COL_K = 1024, COL_B = 1536, COL_C = 2560, COL_U = 3584;
constexpr float EPS = 1e-6f, LOG2E = 1.4426950408889634f;
constexpr int NTHR = 512, LDS_BYTES = 147456;
constexpr size_t MiB = 1u << 20;
constexpr size_t WS_WOUT = 0, WS_WGU = 8 * MiB, WS_WD = 52 * MiB, WS_WIN = 74 * MiB, WS_H = 92 * MiB  , WS_PROJ = 124 * MiB;
constexpr size_t WS_ACT = 74 * MiB  , WS_X1B = 162 * MiB  , WS_SSQ = 200 * MiB, WS_CTL = 201 * MiB  , CTL_BYTES = 32768, WS_MIX = 204 * MiB  , WS_END = 236 * MiB;
static_assert(WS_ACT + (size_t)MTOK * FF * 2 <= WS_X1B && WS_X1B + (size_t)(MTOK + 2) * DM * 2 <= WS_PROJ + (size_t)MTOK * INW * 2 && WS_PROJ + (size_t)MTOK * INW * 2 <= WS_SSQ, "ws map");

__device__ __forceinline__ unsigned cvt_pk_bf16(float lo, float hi) { unsigned r; asm volatile("v_cvt_pk_bf16_f32 %0, %1, %2" : "=v"(r) : "v"(lo), "v"(hi)); return r; }
__device__ __forceinline__ float bf_lo(unsigned w) { return __uint_as_float(w << 16); }
__device__ __forceinline__ float bf_hi(unsigned w) { return __uint_as_float(w & 0xffff0000u); }
#define LDS_WAIT() asm volatile("s_waitcnt lgkmcnt(0)" ::: "memory")
__device__ __forceinline__ int opaque_v(int v) { asm volatile("" : "+v"(v)); return v; }

namespace pg8 {
constexpr int BM = 256, BK = 64, HALF = 128, HTB = HALF * BK * 2, STAGE_BYTES = 8 * HTB, NXCD = 8, WGM = 8;
__host__ __device__ __forceinline__ int lds_byte(int r, int c) { const int st = (r >> 4) * 2 + (c >> 5), rr = r & 15, cc = c & 31, ob = rr * 64 + cc * 2; return st * 1024 + (ob ^ (((ob >> 9) & 1) << 5)); }
__host__ __device__ __forceinline__ void stage_rc(int b, int& R, int& C) { const int st = b / 1024, sb = b % 1024, swz = sb ^ (((sb >> 9) & 1) << 5); R = (st >> 1) * 16 + swz / 64; C = (st & 1) * 32 + (swz % 64) / 2; }
__host__ __device__ __forceinline__ int perm32(int rho) { const int n = rho >> 4, i = rho & 15; return 8 * (i >> 2) + 4 * n + (i & 3); }

struct Unit { int pm, pn, arow; };
struct Gemm { const bf16_t* A; const bf16_t* Bt; int K; };

struct Order {
    int nM, nN, nwg, G, c, mode;
    __device__ void init(int nM_, int nN_, int G_, int c_, int mode_) { nM = nM_; nN = nN_; nwg = nM * nN; G = G_; c = c_; mode = mode_; }
    __device__ bool next(int i, Unit& u) const {
        if (mode == 2 && i >= 2) {
            if (i > 2 || (c & 7) >= 2) return false;
            u.pn = (c & 7) == 0 ? 8 : 17; u.pm = c >> 3; u.arow = u.pm * BM; return true; }
        const long L = (long)i * G + c; if (L >= nwg) return false;
        int wgid = (int)L; { const int q = nwg / NXCD, r = nwg % NXCD, xcd = wgid % NXCD, off = wgid / NXCD; wgid = (xcd < r ? xcd * (q + 1) : r * (q + 1) + (xcd - r) * q) + off; }
        const int nig = WGM * nN, gid = wgid / nig, fm = gid * WGM, gsz = (nM - fm) < WGM ? (nM - fm) : WGM;
        u.pm = fm + ((wgid % nig) % gsz); u.pn = (wgid % nig) / gsz;
        if (mode != 1) u.arow = u.pm * BM;
        else { const int b = u.pm / 17, j = u.pm % 17; int T0 = 248 * j; if (T0 > 3848) T0 = 3848; u.arow = b * SEQ + T0 - 1; }
        return true;
    }
};

struct EpiBf16 {
    static constexpr bool AFTER_DRAIN = false;
    bf16_t* O; int ldc; const float* rs;
    __device__ __forceinline__ void operator()(const f32x4 (&acc)[2][2][4][2], const Unit& u, int wr, int wc, int fr, int fq) const {
        const int row0 = u.pm * BM + wr * 64 + fr, col0 = u.pn * BM + wc * 32 + 8 * fq;
        float rv[2][4];
#pragma unroll
        for (int ai = 0; ai < 2; ++ai)
#pragma unroll
            for (int m = 0; m < 4; ++m) rv[ai][m] = rs[row0 + ai * HALF + m * 16];
#pragma unroll
        for (int ai = 0; ai < 2; ++ai)
#pragma unroll
            for (int m = 0; m < 4; ++m) { bf16_t* rowp = O + (size_t)(row0 + ai * HALF + m * 16) * ldc + col0; const float r = rv[ai][m];
#pragma unroll
                for (int bj = 0; bj < 2; ++bj) { const f32x4 v0 = acc[ai][bj][m][0] * r, v1 = acc[ai][bj][m][1] * r;
                    u32x4 w; w.x = cvt_pk_bf16(v0[0], v0[1]); w.y = cvt_pk_bf16(v0[2], v0[3]); w.z = cvt_pk_bf16(v1[0], v1[1]); w.w = cvt_pk_bf16(v1[2], v1[3]);
                    *(u32x4*)(rowp + bj * HALF) = w; } }
    }
};
struct EpiRes1 {
    static constexpr bool AFTER_DRAIN = true;
    const bf16_t* base; bf16_t* xb; float* ssq; unsigned* cnt; float* r2out;
    __device__ __forceinline__ void fused(f32x4 (&acc)[2][2][4][2], const Unit& u, int wr, int wc, int fr, int fq, LAS unsigned char* lds, int wid, int lane) const {
        LAS float* P = (LAS float*)lds;
        const int col0 = u.pn * BM + wc * 32 + 8 * fq;
#pragma unroll
        for (int ai = 0; ai < 2; ++ai) {
            u32x4 pre[4][2];
#pragma unroll
            for (int m = 0; m < 4; ++m) { const size_t off = (size_t)(u.pm * BM + ai * HALF + wr * 64 + m * 16 + fr) * DM + col0;
#pragma unroll
                for (int bj = 0; bj < 2; ++bj) pre[m][bj] = *(const u32x4*)(base + off + bj * HALF); }
            asm volatile("" ::: "memory");
#pragma unroll
            for (int m = 0; m < 4; ++m) { const int rl = ai * HALF + wr * 64 + m * 16 + fr; const size_t off = (size_t)(u.pm * BM + rl) * DM + col0; float s = 0.f;
#pragma unroll
                for (int bj = 0; bj < 2; ++bj) { const u32x4 pw = pre[m][bj]; const f32x4 b0 = (f32x4){bf_lo(pw.x), bf_hi(pw.x), bf_lo(pw.y), bf_hi(pw.y)}, b1 = (f32x4){bf_lo(pw.z), bf_hi(pw.z), bf_lo(pw.w), bf_hi(pw.w)};
                    const f32x4 v0 = acc[ai][bj][m][0] + b0, v1 = acc[ai][bj][m][1] + b1;
                    u32x4 w; w.x = cvt_pk_bf16(v0[0], v0[1]); w.y = cvt_pk_bf16(v0[2], v0[3]); w.z = cvt_pk_bf16(v1[0], v1[1]); w.w = cvt_pk_bf16(v1[2], v1[3]);
                    *(u32x4*)(xb + off + bj * HALF) = w;
                    s += (v0[0] * v0[0] + v0[1] * v0[1]) + (v0[2] * v0[2] + v0[3] * v0[3]) + (v1[0] * v1[0] + v1[1] * v1[1]) + (v1[2] * v1[2] + v1[3] * v1[3]); }
                s += __shfl_xor(s, 16); s += __shfl_xor(s, 32);
                if (fq == 0) P[rl * 4 + wc] = s; }
            asm volatile("" ::: "memory");
        }
        __syncthreads();
        const int tid = wid * 64 + lane;
        if (tid < 256) __hip_atomic_store(ssq + (size_t)(u.pm * BM + tid) * 8 + u.pn, (P[tid * 4 + 0] + P[tid * 4 + 1]) + (P[tid * 4 + 2] + P[tid * 4 + 3]), __ATOMIC_RELAXED, __HIP_MEMORY_SCOPE_AGENT);
        asm volatile("s_waitcnt vmcnt(0)" ::: "memory");
        __syncthreads();
        LAS unsigned* flag = (LAS unsigned*)(lds + 4096);
        if (tid == 0) { const unsigned old = __hip_atomic_fetch_add(cnt + 64 * u.pm, 1u, __ATOMIC_RELAXED, __HIP_MEMORY_SCOPE_AGENT);
            if (old == 7u) { __builtin_amdgcn_fence(__ATOMIC_ACQUIRE, "agent"); asm volatile("s_waitcnt vmcnt(0)" ::: "memory"); }
            flag[0] = (old == 7u) ? 1u : 0u; }
        __syncthreads();
        if (flag[0] != 0u && tid < 256) { const float* sp8 = ssq + (size_t)(u.pm * BM + tid) * 8; float t = 0.f;
#pragma unroll
            for (int k = 0; k < 8; ++k) t += __hip_atomic_load(sp8 + k, __ATOMIC_RELAXED, __HIP_MEMORY_SCOPE_AGENT);
            r2out[u.pm * BM + tid] = __builtin_amdgcn_rsqf(t * (1.0f / DM) + EPS); }
    }
};
struct EpiFinal {
    static constexpr bool AFTER_DRAIN = true;
    const bf16_t* base; float* out; float* ssq2; unsigned* cnt; const float* w;
    __device__ __forceinline__ void fused(f32x4 (&acc)[2][2][4][2], const Unit& u, int wr, int wc, int fr, int fq, LAS unsigned char* lds, int wid, int lane) const {
        LAS float* P = (LAS float*)lds;
        LAS float* S = P + 1024;
        const int col0 = u.pn * BM + wc * 32 + 8 * fq;
        f32x4 wv[2][2];
#pragma unroll
        for (int bj = 0; bj < 2; ++bj) { wv[bj][0] = *(const f32x4*)(w + col0 + bj * HALF); wv[bj][1] = *(const f32x4*)(w + col0 + bj * HALF + 4); }
#pragma unroll
        for (int ai = 0; ai < 2; ++ai) {
            u32x4 pre[4][2];
#pragma unroll
            for (int m = 0; m < 4; ++m) { const size_t off = (size_t)(u.pm * BM + ai * HALF + wr * 64 + m * 16 + fr) * DM + col0;
#pragma unroll
                for (int bj = 0; bj < 2; ++bj) pre[m][bj] = __builtin_nontemporal_load((const u32x4*)(base + off + bj * HALF)); }
            asm volatile("" ::: "memory");
#pragma unroll
            for (int m = 0; m < 4; ++m) { const int rl = ai * HALF + wr * 64 + m * 16 + fr; float s = 0.f;
#pragma unroll
                for (int bj = 0; bj < 2; ++bj) { const u32x4 pw = pre[m][bj]; const f32x4 b0 = (f32x4){bf_lo(pw.x), bf_hi(pw.x), bf_lo(pw.y), bf_hi(pw.y)}, b1 = (f32x4){bf_lo(pw.z), bf_hi(pw.z), bf_lo(pw.w), bf_hi(pw.w)};
                    const f32x4 v0 = acc[ai][bj][m][0] + b0, v1 = acc[ai][bj][m][1] + b1; acc[ai][bj][m][0] = v0; acc[ai][bj][m][1] = v1;
                    s += (v0[0] * v0[0] + v0[1] * v0[1]) + (v0[2] * v0[2] + v0[3] * v0[3]) + (v1[0] * v1[0] + v1[1] * v1[1]) + (v1[2] * v1[2] + v1[3] * v1[3]); }
                s += __shfl_xor(s, 16); s += __shfl_xor(s, 32);
                if (fq == 0) P[rl * 4 + wc] = s; }
        }
        __syncthreads();
        const int tid = wid * 64 + lane;
        if (tid < 256) __hip_atomic_store(ssq2 + (size_t)(u.pm * BM + tid) * 8 + u.pn, (P[tid * 4 + 0] + P[tid * 4 + 1]) + (P[tid * 4 + 2] + P[tid * 4 + 3]), __ATOMIC_RELAXED, __HIP_MEMORY_SCOPE_AGENT);
        asm volatile("s_waitcnt vmcnt(0)" ::: "memory");
        __syncthreads();
        if (tid == 0) {
            unsigned* c = cnt + 64 * u.pm;
            __hip_atomic_fetch_add(c, 1u, __ATOMIC_RELAXED, __HIP_MEMORY_SCOPE_AGENT);
            unsigned sp = 0u;
            while (__hip_atomic_load(c, __ATOMIC_RELAXED, __HIP_MEMORY_SCOPE_AGENT) < 8u) { __builtin_amdgcn_s_sleep(2); if (++sp > (1u << 22)) break; }
            __builtin_amdgcn_fence(__ATOMIC_ACQUIRE, "agent");
            asm volatile("s_waitcnt vmcnt(0)" ::: "memory");
        }
        __syncthreads();
        if (tid < 256) { const float* sp8 = ssq2 + (size_t)(u.pm * BM + tid) * 8; float t = 0.f;
#pragma unroll
            for (int k = 0; k < 8; ++k) t += __hip_atomic_load(sp8 + k, __ATOMIC_RELAXED, __HIP_MEMORY_SCOPE_AGENT);
            S[tid] = 1.0f / sqrtf(t * (1.0f / DM) + EPS); }
        __syncthreads();
#pragma unroll
        for (int ai = 0; ai < 2; ++ai)
#pragma unroll
            for (int m = 0; m < 4; ++m) { const int rl = ai * HALF + wr * 64 + m * 16 + fr; const size_t off = (size_t)(u.pm * BM + rl) * DM + col0; const float r = S[rl];
#pragma unroll
                for (int bj = 0; bj < 2; ++bj) { *(f32x4*)(out + off + bj * HALF) = acc[ai][bj][m][0] * r * wv[bj][0]; *(f32x4*)(out + off + bj * HALF + 4) = acc[ai][bj][m][1] * r * wv[bj][1]; } }
    }
};
struct EpiFfn {
    static constexpr bool AFTER_DRAIN = false;
    bf16_t* act; const float* r2; const float* cw; const float* cb;
    __device__ __forceinline__ void operator()(f32x4 (&acc)[2][2][4][2], const Unit& u, int wr, int wc, int fr, int fq) const {
        const int b = u.pm / 17, j = u.pm % 17; int T0 = 248 * j; if (T0 > 3848) T0 = 3848;
        const int ch0 = u.pn * HALF + wc * 32 + 8 * fq;
        float r2v[2][4]; int tt[2][4];
#pragma unroll
        for (int ai = 0; ai < 2; ++ai)
#pragma unroll
            for (int m = 0; m < 4; ++m) { const int t = T0 + 62 * (2 * ai + wr) + 16 * m + fr - 1; tt[ai][m] = t; const int tc = t < 0 ? 0 : (t > SEQ - 1 ? SEQ - 1 : t); r2v[ai][m] = r2[b * SEQ + tc]; }
        f32x4 w0[2], w1[2], w2[2], bb[2];
#pragma unroll
        for (int n = 0; n < 2; ++n) { w0[n] = *(const f32x4*)(cw + ch0 + 4 * n); w1[n] = *(const f32x4*)(cw + FF + ch0 + 4 * n); w2[n] = *(const f32x4*)(cw + 2 * FF + ch0 + 4 * n); bb[n] = *(const f32x4*)(cb + ch0 + 4 * n); }
        asm volatile("" ::: "memory");
        const bool edge = (j == 0) || (j == 16);
        if (edge) {
#pragma unroll
            for (int ai = 0; ai < 2; ++ai)
#pragma unroll
                for (int m = 0; m < 4; ++m) if (tt[ai][m] < 0 || tt[ai][m] > SEQ - 1) { acc[ai][0][m][0] = (f32x4){0.f, 0.f, 0.f, 0.f}; acc[ai][0][m][1] = (f32x4){0.f, 0.f, 0.f, 0.f}; } }
        body<false>(acc, r2v, tt, w0, w1, w2, bb, b, ch0, fr);
    }
    template <bool EDGE> __device__ __forceinline__ void body(f32x4 (&acc)[2][2][4][2], const float (&r2v)[2][4], const int (&tt)[2][4], const f32x4 (&w0)[2], const f32x4 (&w1)[2], const f32x4 (&w2)[2], const f32x4 (&bb)[2], int b, int ch0, int fr) const {
#pragma unroll
        for (int ai = 0; ai < 2; ++ai) {
#pragma unroll
            for (int m = 0; m < 4; ++m) { const float r = r2v[ai][m];
#pragma unroll
                for (int n = 0; n < 2; ++n) { acc[ai][0][m][n] = acc[ai][0][m][n] * r; acc[ai][1][m][n] = acc[ai][1][m][n] * r; } }
            unsigned res[4][4];
#pragma unroll
            for (int n = 0; n < 2; ++n) {
#pragma unroll
                for (int ep = 0; ep < 2; ++ep) {
                    const f32x2 w0p = {w0[n][2 * ep], w0[n][2 * ep + 1]}, w1p = {w1[n][2 * ep], w1[n][2 * ep + 1]}, w2p = {w2[n][2 * ep], w2[n][2 * ep + 1]}, bbp = {bb[n][2 * ep], bb[n][2 * ep + 1]};
#pragma unroll
                    for (int m = 0; m < 4; ++m) {
                        const f32x2 g = {acc[ai][0][m][n][2 * ep], acc[ai][0][m][n][2 * ep + 1]};
                        const f32x2 gm = {acc[ai][0][m > 0 ? m - 1 : 0][n][2 * ep], acc[ai][0][m > 0 ? m - 1 : 0][n][2 * ep + 1]}, gp = {acc[ai][0][m < 3 ? m + 1 : 3][n][2 * ep], acc[ai][0][m < 3 ? m + 1 : 3][n][2 * ep + 1]};
                        const bool selp = (fr == 15 && m > 0), seln = (fr == 0 && m < 3);
                        const float ps0 = selp ? gm[0] : g[0], ps1 = selp ? gm[1] : g[1], ns0 = seln ? gp[0] : g[0], ns1 = seln ? gp[1] : g[1];
                        f32x2 prev, next;
                        prev[0] = __int_as_float(__builtin_amdgcn_update_dpp(0, __float_as_int(ps0), 0x121  , 0xF, 0xF, false));
                        prev[1] = __int_as_float(__builtin_amdgcn_update_dpp(0, __float_as_int(ps1), 0x121, 0xF, 0xF, false));
                        next[0] = __int_as_float(__builtin_amdgcn_update_dpp(0, __float_as_int(ns0), 0x12F  , 0xF, 0xF, false));
                        next[1] = __int_as_float(__builtin_amdgcn_update_dpp(0, __float_as_int(ns1), 0x12F, 0xF, 0xF, false));
                        const f32x2 gc = w0p * prev + (w1p * g + (w2p * next + bbp));
                        f32x2 ex = gc * (-LOG2E); ex[0] = __builtin_amdgcn_exp2f(ex[0]); ex[1] = __builtin_amdgcn_exp2f(ex[1]);
                        const f32x2 den = ex + 1.0f; f32x2 sg; sg[0] = __builtin_amdgcn_rcpf(den[0]); sg[1] = __builtin_amdgcn_rcpf(den[1]);
                        const f32x2 up = {acc[ai][1][m][n][2 * ep], acc[ai][1][m][n][2 * ep + 1]};
                        const f32x2 rs = gc * sg * up;
                        res[m][2 * n + ep] = cvt_pk_bf16(rs[0], rs[1]); } }
            }
#pragma unroll
            for (int m = 0; m < 4; ++m) { const int q = 16 * m + fr;
                if (q >= 1 && q <= 62) { u32x4 w; w.x = res[m][0]; w.y = res[m][1]; w.z = res[m][2]; w.w = res[m][3];
                    *(u32x4*)(act + (size_t)(b * SEQ + tt[ai][m]) * FF + ch0) = w; } }
        }
    }
};

template <class Epi, bool STRIP, bool ALIGN_EPI>
__device__ __forceinline__ void gemm_phase(LAS unsigned char* lds, const Gemm g, const Order& S, Epi& E) {
    const int tid = opaque_v(threadIdx.x), wid = __builtin_amdgcn_readfirstlane(tid >> 6), lane = tid & 63, wr = wid >> 2, wc = wid & 3, fr = lane & 15, fq = lane >> 4;
    const int K = g.K, nt = K / BK;
    unsigned voffA[2], voffB[2];
#pragma unroll
    for (int i = 0; i < 2; ++i) { int R, C; stage_rc(tid * 16 + i * 8192, R, C); const int Rb = (R & ~31) + perm32(R & 31); const int Ra = STRIP ? (62 * (R >> 6) + (R & 63)) : R;
        voffA[i] = (unsigned)(Ra * K + C) * 2u; voffB[i] = (unsigned)(Rb * K + C) * 2u; }
    const size_t kstep = (size_t)(BK * 2);
    const size_t hstepB = (size_t)HALF * K * 2, hstepA = (size_t)(STRIP ? 124 : HALF) * K * 2;
    const size_t tstepB = 2 * hstepB;
    const long rowb = (long)K * 2;
    const unsigned ldsw = (unsigned)wid * 1024u;
    const int aoff = lds_byte(wr * 64 + fr, fq * 8), boff = lds_byte(wc * 32 + fr, fq * 8);
#define PG8_SA(b, h) (((b) * 2 + (h)) * HTB)
#define PG8_SB(b, h) ((4 + (b) * 2 + (h)) * HTB)
#define PG8_STAGE(bufoff, gbase, voff) do { _Pragma("unroll") for (int _i = 0; _i < 2; ++_i) \
        __builtin_amdgcn_global_load_lds((const unsigned*)((const char*)(gbase) + (voff)[_i]), (LAS unsigned*)(lds + (bufoff) + ldsw + _i * 8192), 16, 0, 0); } while (0)
#define PG8_LDA(dst, b, h) do { _Pragma("unroll") for (int m = 0; m < 4; ++m) _Pragma("unroll") for (int k = 0; k < 2; ++k) dst[m][k] = *(const LAS bf16x8*)(lds + PG8_SA(b, h) + aoff + m * 2048 + k * 1024); } while (0)
#define PG8_LDB(dst, b, h) do { _Pragma("unroll") for (int n = 0; n < 2; ++n) _Pragma("unroll") for (int k = 0; k < 2; ++k) dst[n][k] = *(const LAS bf16x8*)(lds + PG8_SB(b, h) + boff + n * 2048 + k * 1024); } while (0)
#define PG8_MMA(ai, bj, At, Bt) do { __builtin_amdgcn_s_setprio(1); _Pragma("unroll") for (int m = 0; m < 4; ++m) _Pragma("unroll") for (int n = 0; n < 2; ++n) _Pragma("unroll") for (int k = 0; k < 2; ++k) \
        acc[ai][bj][m][n] = __builtin_amdgcn_mfma_f32_16x16x32_bf16(Bt[n][k], At[m][k], acc[ai][bj][m][n], 0, 0, 0); __builtin_amdgcn_s_setprio(0); } while (0)
#define PG8_WAIT_V(n) asm volatile("s_waitcnt vmcnt(" #n ")" ::: "memory")
#define PG8_WAIT_L(n) asm volatile("s_waitcnt lgkmcnt(" #n ")" ::: "memory")
#define PG8_BAR __builtin_amdgcn_s_barrier()
#define PG8_SCHED __builtin_amdgcn_sched_barrier(0)
    Unit cur, nxt; int ui = 0;
    if (!S.next(0, cur)) return;
    f32x4 acc[2][2][4][2];
#pragma unroll
    for (int a = 0; a < 2; ++a)
#pragma unroll
        for (int b = 0; b < 2; ++b)
#pragma unroll
            for (int m = 0; m < 4; ++m)
#pragma unroll
                for (int n = 0; n < 2; ++n) acc[a][b][m][n] = (f32x4){0.f, 0.f, 0.f, 0.f};
    bf16x8 At[4][2], B0[2][2], B1[2][2];
    const char* cA = (const char*)g.A + (long)cur.arow * rowb; const char* cB = (const char*)g.Bt + (size_t)cur.pn * tstepB;
    PG8_STAGE(PG8_SB(0, 0), cB, voffB); PG8_STAGE(PG8_SB(0, 1), cB + hstepB, voffB); PG8_STAGE(PG8_SA(0, 0), cA, voffA); PG8_STAGE(PG8_SA(0, 1), cA + hstepA, voffA);
    if (wr == 1) PG8_BAR;
    PG8_WAIT_V(2); PG8_BAR;
    PG8_STAGE(PG8_SB(1, 0), cB + kstep, voffB); PG8_STAGE(PG8_SA(1, 0), cA + kstep, voffA); PG8_STAGE(PG8_SB(1, 1), cB + hstepB + kstep, voffB);
    PG8_WAIT_V(6); PG8_BAR;
    for (;;) {
        const bool has_next = S.next(ui + 1, nxt);
        const char* nA = has_next ? (const char*)g.A + (long)nxt.arow * rowb : cA; const char* nB = has_next ? (const char*)g.Bt + (size_t)nxt.pn * tstepB : cB;
        for (int t = 0; t < nt; t += 2) {
            const bool last = (t == nt - 2);
            const char* a1 = cA + (size_t)(t + 1) * kstep;
            const char* a2 = last ? nA : cA + (size_t)(t + 2) * kstep; const char* b2 = last ? nB : cB + (size_t)(t + 2) * kstep;
            const char* a3 = a2 + kstep; const char* b3 = b2 + kstep;
            PG8_LDB(B0, 0, 0); PG8_LDB(B1, 0, 1); PG8_SCHED; PG8_LDA(At, 0, 0); PG8_STAGE(PG8_SA(1, 1), a1 + hstepA, voffA);
            PG8_WAIT_V(8); PG8_WAIT_L(0); PG8_BAR; PG8_MMA(0, 0, At, B0); PG8_MMA(0, 1, At, B1); PG8_BAR; PG8_SCHED;
            PG8_LDA(At, 0, 1); PG8_STAGE(PG8_SB(0, 0), b2, voffB); PG8_STAGE(PG8_SB(0, 1), b2 + hstepB, voffB); PG8_STAGE(PG8_SA(0, 0), a2, voffA);
            PG8_WAIT_V(8); PG8_WAIT_L(0); PG8_BAR; PG8_MMA(1, 0, At, B0); PG8_MMA(1, 1, At, B1); PG8_BAR; PG8_SCHED;
            PG8_LDB(B0, 1, 0); PG8_LDB(B1, 1, 1); PG8_SCHED; PG8_LDA(At, 1, 0); PG8_STAGE(PG8_SA(0, 1), a2 + hstepA, voffA);
            PG8_WAIT_V(8); PG8_WAIT_L(0); PG8_BAR; PG8_MMA(0, 0, At, B0); PG8_MMA(0, 1, At, B1); PG8_BAR; PG8_SCHED;
            PG8_LDA(At, 1, 1); PG8_STAGE(PG8_SB(1, 0), b3, voffB); PG8_STAGE(PG8_SB(1, 1), b3 + hstepB, voffB); PG8_STAGE(PG8_SA(1, 0), a3, voffA);
            PG8_WAIT_V(8); PG8_WAIT_L(0); PG8_BAR; PG8_MMA(1, 0, At, B0); PG8_MMA(1, 1, At, B1); PG8_BAR; PG8_SCHED;
        }
        if constexpr (ALIGN_EPI) { if (wr == 0) PG8_BAR; }
        if constexpr (!Epi::AFTER_DRAIN) { E(acc, cur, wr, wc, fr, fq); }
        if (!has_next) break;
#pragma unroll
        for (int a = 0; a < 2; ++a)
#pragma unroll
            for (int b = 0; b < 2; ++b)
#pragma unroll
                for (int m = 0; m < 4; ++m)
#pragma unroll
                    for (int n = 0; n < 2; ++n) acc[a][b][m][n] = (f32x4){0.f, 0.f, 0.f, 0.f};
        cur = nxt; cA = nA; cB = nB; ++ui;
        if constexpr (ALIGN_EPI) { if (wr == 1) PG8_BAR; }
    }
    PG8_WAIT_V(0);
    if constexpr (!ALIGN_EPI) { if (wr == 0) PG8_BAR; }
    PG8_BAR;
    if constexpr (Epi::AFTER_DRAIN) { E.fused(acc, cur, wr, wc, fr, fq, lds, wid, lane); }
#undef PG8_SA
#undef PG8_SB
#undef PG8_STAGE
#undef PG8_LDA
#undef PG8_LDB
#undef PG8_MMA
#undef PG8_WAIT_V
#undef PG8_WAIT_L
#undef PG8_BAR
#undef PG8_SCHED
}
}

struct Args {
    const float* x; const float* attn_norm_w; const float* w_in; const float* sink; const float* mix_w; const float* mix_b; const float* aon_w; const float* con_w;
    const float* w_out; const float* ffn_norm_w; const float* w_gate; const float* w_up; const float* ffn_cw; const float* ffn_cb; const float* w_down; const float* final_w;
    float* out; unsigned char* ws;
    int cg_seam; int pad;
};

__device__ __forceinline__ float wave_sum(float v) {
#pragma unroll
    for (int o = 1; o < 64; o <<= 1) v += __shfl_xor(v, o);
    return v;
}

__device__ __forceinline__ void p0_transpose_item(const float* __restrict__ W, int N, const float* __restrict__ fold, bf16_t* WT, int ldt, int k0, int n0, int drow0, LAS unsigned* scr, int lane) {
    const int nq = lane & 15, kg = lane >> 4;
    f32x4 va[8], vb[8]; f32x2 fv[8];
#pragma unroll
    for (int s = 0; s < 8; ++s) { const float* p = W + (size_t)(k0 + 2 * (kg + 4 * s)) * N + n0 + 4 * nq; va[s] = __builtin_nontemporal_load((const f32x4*)p); vb[s] = __builtin_nontemporal_load((const f32x4*)(p + N));
        fv[s] = fold ? *(const f32x2*)(fold + k0 + 2 * (kg + 4 * s)) : (f32x2){1.f, 1.f}; }
#pragma unroll
    for (int s = 0; s < 8; ++s) { const int kp = kg + 4 * s; const float f0 = fv[s][0], f1 = fv[s][1];
        LAS unsigned* d = scr + kp * 65 + 4 * nq;
        d[0] = cvt_pk_bf16(va[s][0] * f0, vb[s][0] * f1); d[1] = cvt_pk_bf16(va[s][1] * f0, vb[s][1] * f1); d[2] = cvt_pk_bf16(va[s][2] * f0, vb[s][2] * f1); d[3] = cvt_pk_bf16(va[s][3] * f0, vb[s][3] * f1); }
    LDS_WAIT();
    const int c = lane & 7;
#pragma unroll
    for (int j = 0; j < 8; ++j) { const int n = (lane >> 3) + 8 * j; const LAS unsigned* s = scr + (4 * c) * 65 + n;
        u32x4 o; o.x = s[0]; o.y = s[65]; o.z = s[130]; o.w = s[195];
        *(u32x4*)(WT + (size_t)(drow0 + n) * ldt + k0 + 8 * c) = o; }
    LDS_WAIT();
}
__device__ __forceinline__ void p0_convert(const Args& a, LAS unsigned char* lds, int lane, int wave, int it_lo, int it_hi, int widx, int nworkers) {
    lane = opaque_v(lane);
    LAS unsigned* scr = (LAS unsigned*)(lds + wave * 8320);
    bf16_t* Win_t = (bf16_t*)(a.ws + WS_WIN); bf16_t* Wout_t = (bf16_t*)(a.ws + WS_WOUT); bf16_t* Wgu_t = (bf16_t*)(a.ws + WS_WGU); bf16_t* Wd_t = (bf16_t*)(a.ws + WS_WD);
    constexpr int I_IN = 32 * 72, I_OUT = 32 * 32, I_G = 32 * 88;
    for (int it = it_lo + widx; it < it_hi; it += nworkers) {
        int r = it, kb, nb, N, ldt, drow0; const float* W; const float* fold; bf16_t* WT;
        if (r < I_IN) { kb = r / 72; nb = r % 72; W = a.w_in; N = INW; fold = a.attn_norm_w; WT = Win_t; ldt = DM; drow0 = 64 * nb; }
        else if ((r -= I_IN) < I_OUT) { kb = r / 32; nb = r % 32; W = a.w_out; N = DM; fold = kb < 16 ? a.aon_w : a.con_w - 1024; WT = Wout_t; ldt = DM; drow0 = 64 * nb; }
        else if ((r -= I_OUT) < I_G) { kb = r / 88; nb = r % 88; W = a.w_gate; N = FF; fold = a.ffn_norm_w; WT = Wgu_t; ldt = DM; drow0 = ((64 * nb) >> 7) * 256 + ((64 * nb) & 127); }
        else if ((r -= I_G) < I_G) { kb = r / 88; nb = r % 88; W = a.w_up; N = FF; fold = a.ffn_norm_w; WT = Wgu_t; ldt = DM; drow0 = ((64 * nb) >> 7) * 256 + 128 + ((64 * nb) & 127); }
        else { r -= I_G; kb = r / 32; nb = r % 32; W = a.w_down; N = DM; fold = nullptr; WT = Wd_t; ldt = FF; drow0 = 64 * nb; }
        p0_transpose_item(W, N, fold, WT, ldt, 64 * kb, 64 * nb, drow0, scr, lane);
    }
}
constexpr int P0_ITEMS_EARLY = 32 * 72 + 32 * 32, P0_ITEMS_GU = 32 * 72 + 32 * 32 + 2 * 32 * 88, P0_ITEMS_ALL = P0_ITEMS_GU + 88 * 32, P0_ITEMS_SPLIT = P0_ITEMS_GU + 936;
__device__ __forceinline__ void p0_prologue(const Args& a, LAS unsigned char* lds, int lane, int wave) {
    const int gw = blockIdx.x * 8 + wave, NGW = gridDim.x * 8;
    p0_convert(a, lds, lane, wave, 0, P0_ITEMS_EARLY, gw, NGW);
    lane = opaque_v(lane);
    bf16_t* H = (bf16_t*)(a.ws + WS_H);
    int row_lo, row_n;
    { const int n2 = P0_ITEMS_EARLY - NGW;
      if (NGW == 2048 && n2 == 1280) { if (gw < n2) { row_lo = 3 * gw; row_n = 3; } else { row_lo = 3 * n2 + 5 * (gw - n2); row_n = 5; } }
      else { row_lo = gw * (MTOK / NGW); row_n = MTOK / NGW; } }
    for (int mi = 0; mi < row_n + 1; ++mi) {
        int m = row_lo + mi;
        if (mi == row_n) { if (NGW == 2048 && P0_ITEMS_EARLY - NGW == 1280 && gw < 512) m = 7680 + gw; else break; }
        const f32x4* xr = (const f32x4*)(a.x + (size_t)m * DM) + lane; f32x4 v[8]; float s = 0.f;
#pragma unroll
        for (int j = 0; j < 8; ++j) { v[j] = __builtin_nontemporal_load(xr + 64 * j); s += (v[j][0] * v[j][0] + v[j][1] * v[j][1]) + (v[j][2] * v[j][2] + v[j][3] * v[j][3]); }
        const float rn = 1.0f / sqrtf(wave_sum(s) * (1.0f / DM) + EPS);
        if (lane == 0) ((float*)(a.ws + WS_SSQ) + (size_t)MTOK * 17)[m] = rn;
        u32x2* o8 = (u32x2*)(H + (size_t)m * DM) + lane;
#pragma unroll
        for (int j = 0; j < 8; ++j) { u32x2 o; o.x = cvt_pk_bf16(v[j][0], v[j][1]); o.y = cvt_pk_bf16(v[j][2], v[j][3]); o8[64 * j] = o; }
    }
}

__device__ __forceinline__ s16x4 tr16(const LAS unsigned char* p) { return __builtin_bit_cast(s16x4, __builtin_amdgcn_ds_read_tr16_b64_v4i16((LAS s16x4*)p)); }
__device__ __forceinline__ void p2_attn_conv(const Args& a, LAS unsigned char* lds, int tid, int lane, int wid) {
    tid = opaque_v(tid); lane = tid & 63;
    constexpr int RS = 1040, KVB = 32 * RS, NBUF = 4;
    const bf16_t* PROJ = (const bf16_t*)(a.ws + WS_PROJ); bf16_t* MIXED = (bf16_t*)(a.ws + WS_MIX);
    LAS float* red = (LAS float*)(lds + NBUF * KVB);
    LAS float* red2 = red + 256;
#define P2_WAITV(n) asm volatile("s_waitcnt vmcnt(" #n ")" ::: "memory")
    const int vcu = (gridDim.x % 8 == 0) ? (int)((blockIdx.x % 8) * (gridDim.x / 8) + blockIdx.x / 8) : (int)blockIdx.x;
    for (int item = vcu; item < MTOK / 32; item += gridDim.x) {
        tid = opaque_v(tid); lane = tid & 63;
        const int r32 = lane & 31, h = lane >> 5;
        const int b = item >> 7, t0 = (item & 127) * 32; const size_t rowbase = (size_t)b * SEQ;
        int jlo = 4 - (t0 >> 5); if (jlo < 0) jlo = 0;
        int jhi = (SEQ + 128 - t0) >> 5; if (jhi > 9) jhi = 9;
#define P2_DMA(j) do { const bf16_t* src_ = PROJ + (rowbase + (t0 - 128 + 32 * (j)) + wid) * INW + COL_K + lane * 8; LAS unsigned char* dst_ = lds + ((j) & 3) * KVB + wid * RS; \
            _Pragma("unroll") for (int i_ = 0; i_ < 4; ++i_) __builtin_amdgcn_global_load_lds((const unsigned*)(src_ + (size_t)(8 * i_) * INW), (LAS unsigned*)(dst_ + (8 * i_) * RS), 16, 0, 0); } while (0)
        P2_DMA(jlo); P2_DMA(jlo + 1); P2_DMA(jlo + 2);
        {
            const int c0 = (tid & 127) * 8, tg = tid >> 7, tb = t0 + 8 * tg;
            float w0[8], w1[8], w2[8], bb[8];
#pragma unroll
            for (int hh = 0; hh < 2; ++hh) { const f32x4 a0 = *(const f32x4*)(a.mix_w + c0 + 4 * hh), a1 = *(const f32x4*)(a.mix_w + 1024 + c0 + 4 * hh), a2 = *(const f32x4*)(a.mix_w + 2048 + c0 + 4 * hh), a3 = *(const f32x4*)(a.mix_b + c0 + 4 * hh);
#pragma unroll
                for (int e = 0; e < 4; ++e) { w0[4 * hh + e] = a0[e]; w1[4 * hh + e] = a1[e]; w2[4 * hh + e] = a2[e]; bb[4 * hh + e] = a3[e]; } }
            float res[8][8], sq[8];
#pragma unroll
            for (int rd = 0; rd < 2; ++rd) {
                const int tr = tb + 4 * rd;
                u32x4 cv[6], uv[6], bv[4];
#pragma unroll
                for (int tt = 0; tt < 6; ++tt) { const int t = tr - 1 + tt, tc = t < 0 ? 0 : (t > SEQ - 1 ? SEQ - 1 : t); const bf16_t* rp = PROJ + (rowbase + tc) * INW + c0; cv[tt] = __builtin_nontemporal_load((const u32x4*)(rp + COL_C)); uv[tt] = __builtin_nontemporal_load((const u32x4*)(rp + COL_U)); }
#pragma unroll
                for (int i = 0; i < 4; ++i) bv[i] = __builtin_nontemporal_load((const u32x4*)(PROJ + (rowbase + tr + i) * INW + COL_B + c0));
                float cp[8], cc[8], cn[8];
#define P2_CU(dst, tt) do { const int t_ = tr - 1 + (tt); const float ok_ = (t_ >= 0 && t_ < SEQ) ? 1.f : 0.f; \
                _Pragma("unroll") for (int e = 0; e < 4; ++e) { dst[2 * e] = bf_lo(cv[tt][e]) * bf_lo(uv[tt][e]) * ok_; dst[2 * e + 1] = bf_hi(cv[tt][e]) * bf_hi(uv[tt][e]) * ok_; } } while (0)
                P2_CU(cp, 0); P2_CU(cc, 1);
#pragma unroll
                for (int i = 0; i < 4; ++i) {
                    P2_CU(cn, i + 2);
                    float s = 0.f;
#pragma unroll
                    for (int e = 0; e < 8; ++e) { const float bg = (e & 1) ? bf_hi(bv[i][e >> 1]) : bf_lo(bv[i][e >> 1]); const float rv = bg * (w0[e] * cp[e] + w1[e] * cc[e] + w2[e] * cn[e] + bb[e]); res[4 * rd + i][e] = rv; s += rv * rv; }
                    sq[4 * rd + i] = s;
#pragma unroll
                    for (int e = 0; e < 8; ++e) { cp[e] = cc[e]; cc[e] = cn[e]; }
                }
#undef P2_CU
            }
#pragma unroll
            for (int i = 0; i < 8; ++i) sq[i] = wave_sum(sq[i]);
            if (lane == 0) {
#pragma unroll
                for (int i = 0; i < 8; ++i) red2[wid * 8 + i] = sq[i]; }
            __syncthreads();
#pragma unroll
            for (int i = 0; i < 8; ++i) { const float tot = red2[(2 * tg) * 8 + i] + red2[(2 * tg + 1) * 8 + i]; const float rn = 1.0f / sqrtf(tot * (1.0f / 1024.0f) + EPS);
                u32x4 w; w.x = cvt_pk_bf16(res[i][0] * rn, res[i][1] * rn); w.y = cvt_pk_bf16(res[i][2] * rn, res[i][3] * rn); w.z = cvt_pk_bf16(res[i][4] * rn, res[i][5] * rn); w.w = cvt_pk_bf16(res[i][6] * rn, res[i][7] * rn);
                *(u32x4*)(MIXED + (rowbase + tb + i) * DM + 1024 + c0) = w; }
        }
        {
            const int hd = wid, kvh = wid >> 2;
            bf16x8 qf[8];
            { const bf16_t* qp = PROJ + (rowbase + t0 + r32) * INW + hd * 128 + h * 8;
#pragma unroll
              for (int st = 0; st < 8; ++st) qf[st] = __builtin_nontemporal_load((const bf16x8*)(qp + st * 16)); }
            f32x16 o[4];
#pragma unroll
            for (int d = 0; d < 4; ++d)
#pragma unroll
                for (int r = 0; r < 16; ++r) o[d][r] = 0.f;
            float m_run = a.sink[hd] * LOG2E, l_run = (h == 0) ? 1.f : 0.f;
            const float slope2 = exp2f(-(float)(hd + 1)) * LOG2E, c2 = 0.08838834764831845f * LOG2E;
            const int g1 = (lane >> 4) & 1, q4 = (lane & 15) >> 2, p4 = lane & 3;
            P2_WAITV(0);
#pragma unroll
            for (int st = 0; st < 8; ++st) asm volatile("" : "+v"(qf[st]));
            for (int j = jlo; j < jhi; ++j) {
                const int rem = jhi - 1 - j;
                if (rem >= 2) P2_WAITV(8); else if (rem == 1) P2_WAITV(4); else P2_WAITV(0);
                asm volatile("s_waitcnt lgkmcnt(0)" ::: "memory");
                __builtin_amdgcn_s_barrier();
                asm volatile("" ::: "memory");
                if (j + 3 < jhi) P2_DMA(j + 3);
                const LAS unsigned char* kb = lds + (j & 3) * KVB;
                f32x16 s;
#pragma unroll
                for (int r = 0; r < 16; ++r) s[r] = 0.f;
#pragma unroll
                for (int st = 0; st < 8; ++st) { const bf16x8 kf = *(const LAS bf16x8*)(kb + r32 * RS + kvh * 256 + st * 32 + h * 16); s = __builtin_amdgcn_mfma_f32_32x32x16_bf16(kf, qf[st], s, 0, 0, 0); }
                const float basef = (float)(32 * j - 128 + 4 * h - r32);
                float tmax = -1e30f;
                if (j == 0 || j == 8) {
#pragma unroll
                    for (int r = 0; r < 16; ++r) { const float af = fabsf(basef + (float)((r & 3) + 8 * (r >> 2))); float v = s[r] * c2 - slope2 * af; v = (af <= 128.f) ? v : -1e30f; s[r] = v; tmax = fmaxf(tmax, v); }
                } else {
#pragma unroll
                    for (int r = 0; r < 16; ++r) { const float af = fabsf(basef + (float)((r & 3) + 8 * (r >> 2))); const float v = s[r] * c2 - slope2 * af; s[r] = v; tmax = fmaxf(tmax, v); }
                }
                tmax = fmaxf(tmax, __shfl_xor(tmax, 32));
                if (__builtin_amdgcn_ballot_w64(tmax > m_run + 6.0f) != 0ull) {
                    const float m_new = fmaxf(m_run, tmax), alpha = __builtin_amdgcn_exp2f(m_run - m_new); m_run = m_new;
                    l_run *= alpha;
#pragma unroll
                    for (int d = 0; d < 4; ++d)
#pragma unroll
                        for (int r = 0; r < 16; ++r) o[d][r] *= alpha;
                }
                float psum = 0.f;
#pragma unroll
                for (int r = 0; r < 16; ++r) { const float p = __builtin_amdgcn_exp2f(s[r] - m_run); s[r] = p; psum += p; }
                l_run += psum;
                u32x4 pw0, pw1;
                pw0.x = cvt_pk_bf16(s[0], s[1]); pw0.y = cvt_pk_bf16(s[2], s[3]); pw0.z = cvt_pk_bf16(s[4], s[5]); pw0.w = cvt_pk_bf16(s[6], s[7]);
                pw1.x = cvt_pk_bf16(s[8], s[9]); pw1.y = cvt_pk_bf16(s[10], s[11]); pw1.z = cvt_pk_bf16(s[12], s[13]); pw1.w = cvt_pk_bf16(s[14], s[15]);
                const bf16x8 pf0 = __builtin_bit_cast(bf16x8, pw0), pf1 = __builtin_bit_cast(bf16x8, pw1);
                const unsigned vba = (unsigned)(size_t)(kb + (4 * h + q4) * RS + 512 + kvh * 256 + g1 * 32 + p4 * 8);
                s16x4 vlo[8], vhi[8];
#pragma unroll
                for (int d = 0; d < 4; ++d)
#pragma unroll
                    for (int ks = 0; ks < 2; ++ks) {
                        asm volatile("ds_read_b64_tr_b16 %0, %1 offset:%c2" : "=&v"(vlo[2 * d + ks]) : "v"(vba), "i"((16 * ks) * RS + d * 64) : "memory");
                        asm volatile("ds_read_b64_tr_b16 %0, %1 offset:%c2" : "=&v"(vhi[2 * d + ks]) : "v"(vba), "i"((16 * ks + 8) * RS + d * 64) : "memory"); }
                asm volatile("s_waitcnt lgkmcnt(0)" : "+v"(vlo[0]), "+v"(vlo[1]), "+v"(vlo[2]), "+v"(vlo[3]), "+v"(vlo[4]), "+v"(vlo[5]), "+v"(vlo[6]), "+v"(vlo[7]) :: "memory");
                asm volatile("" : "+v"(vhi[0]), "+v"(vhi[1]), "+v"(vhi[2]), "+v"(vhi[3]), "+v"(vhi[4]), "+v"(vhi[5]), "+v"(vhi[6]), "+v"(vhi[7]) :: "memory");
                __builtin_amdgcn_sched_barrier(0);
#pragma unroll
                for (int d = 0; d < 4; ++d)
#pragma unroll
                    for (int ks = 0; ks < 2; ++ks) { const s16x4 lo = vlo[2 * d + ks], hi = vhi[2 * d + ks];
                        const bf16x8 vf = (bf16x8){lo[0], lo[1], lo[2], lo[3], hi[0], hi[1], hi[2], hi[3]};
                        o[d] = __builtin_amdgcn_mfma_f32_32x32x16_bf16(vf, ks ? pf1 : pf0, o[d], 0, 0, 0); }
            }
            const float l_tot = l_run + __shfl_xor(l_run, 32), inv = 1.0f / l_tot;
            float ssq = 0.f;
#pragma unroll
            for (int d = 0; d < 4; ++d)
#pragma unroll
                for (int r = 0; r < 16; ++r) { o[d][r] *= inv; ssq += o[d][r] * o[d][r]; }
            ssq += __shfl_xor(ssq, 32);
            if (h == 0) red[wid * 32 + r32] = ssq;
            __syncthreads();
            float tot = 0.f;
#pragma unroll
            for (int w = 0; w < 8; ++w) tot += red[w * 32 + r32];
            const float rn = 1.0f / sqrtf(tot * (1.0f / 1024.0f) + EPS);
            bf16_t* op = MIXED + (rowbase + t0 + r32) * DM + hd * 128 + 4 * h;
#pragma unroll
            for (int d = 0; d < 4; ++d)
#pragma unroll
                for (int gq = 0; gq < 4; ++gq) { u32x2 w; w.x = cvt_pk_bf16(o[d][4 * gq] * rn, o[d][4 * gq + 1] * rn); w.y = cvt_pk_bf16(o[d][4 * gq + 2] * rn, o[d][4 * gq + 3] * rn);
                    *(u32x2*)(op + d * 32 + 8 * gq) = w; }
        }
#undef P2_DMA
        __syncthreads();
    }
#undef P2_WAITV
}

__device__ __forceinline__ void p6_final(const Args& a, int lane, int wave) {
    lane = opaque_v(lane);
    const int gw = blockIdx.x * 8 + wave, NGW = gridDim.x * 8;
    for (int m = gw; m < MTOK; m += NGW) {
        f32x4* xr = (f32x4*)(a.out + (size_t)m * DM) + lane; f32x4 v[8]; float s = 0.f;
#pragma unroll
        for (int j = 0; j < 8; ++j) { v[j] = xr[64 * j]; s += (v[j][0] * v[j][0] + v[j][1] * v[j][1]) + (v[j][2] * v[j][2] + v[j][3] * v[j][3]); }
        const float rn = 1.0f / sqrtf(wave_sum(s) * (1.0f / DM) + EPS);
#pragma unroll
        for (int j = 0; j < 8; ++j) { const f32x4 w = ((const f32x4*)a.final_w)[lane + 64 * j]; xr[64 * j] = v[j] * rn * w; }
    }
}

#define XB_TMO      128
#define XB_XCNT(j)  (256  + 64 * (j))
#define XB_XSUB(j)  (1280 + 64 * (j))
#define XB_XGEN(j)  (2304 + 64 * (j))
#define XB_TOP      3328
#define XB_TOPGEN   3392
#define XCD_BAR_WORDS 3456
#define XB_SPIN_CAP (1u << 18)
__device__ __forceinline__ unsigned xb_ld(unsigned* p)              { return __hip_atomic_load(p, __ATOMIC_RELAXED, __HIP_MEMORY_SCOPE_AGENT); }
__device__ __forceinline__ unsigned xb_add(unsigned* p, unsigned v) { return __hip_atomic_fetch_add(p, v, __ATOMIC_RELAXED, __HIP_MEMORY_SCOPE_AGENT); }
__device__ __forceinline__ unsigned xb_xcc_id() { return (unsigned)__builtin_amdgcn_s_getreg((3 << 11) | 20) & 0xFu; }
#define XB_SPIN(cond, bar) do { unsigned _sp = 0; while (cond) { __builtin_amdgcn_s_sleep(1); \
    if ((++_sp & 255u) == 0u) { if (xb_ld(&(bar)[XB_TMO])) break; if (_sp > XB_SPIN_CAP) { atomicAdd(&(bar)[XB_TMO], 1u); break; } } } } while (0)
struct XcdBarrier { unsigned* bar; unsigned x; volatile LAS unsigned* st; };
__device__ __forceinline__ XcdBarrier xcd_barrier_post(unsigned* bar, volatile LAS unsigned* st) {
    XcdBarrier b; b.bar = bar; b.x = xb_xcc_id(); b.st = st;
    if (threadIdx.x == 0) (void)xb_add(&bar[XB_XCNT(b.x)], 1u);
    return b;
}
__device__ __forceinline__ void xcd_barrier_complete(unsigned* bar, unsigned x, unsigned& nloc, unsigned& nx) {
    const unsigned G = gridDim.x * gridDim.y * gridDim.z;
    unsigned sum, cnt, mine, sp = 0u;
    for (;;) {
        sum = 0u; cnt = 0u; mine = 0u;
#pragma unroll
        for (unsigned j = 0; j < 16; ++j) { const unsigned c = xb_ld(&bar[XB_XCNT(j)]); sum += c; cnt += (c > 0u) ? 1u : 0u; mine = (j == x) ? c : mine; }
        if (sum == G) break;
        __builtin_amdgcn_s_sleep(1);
        if ((++sp & 255u) == 0u) { if (xb_ld(&bar[XB_TMO])) break; if (sp > XB_SPIN_CAP) { atomicAdd(&bar[XB_TMO], 1u); break; } }
    }
    nloc = mine > 0u ? mine : 1u; nx = cnt > 0u ? cnt : 1u;
}
__device__ __forceinline__ void xcd_barrier(const XcdBarrier& b) {
    asm volatile("s_waitcnt vmcnt(0)" ::: "memory");
    __syncthreads();
    if (threadIdx.x == 0) {
        unsigned* bar = b.bar;
        __builtin_amdgcn_s_waitcnt(0);
        unsigned nloc = b.st[0], nx = b.st[1];
        if (nloc == 0u) { xcd_barrier_complete(bar, b.x, nloc, nx); b.st[0] = nloc; b.st[1] = nx; }
        const unsigned old = xb_add(&bar[XB_XSUB(b.x)], 1u);
        const unsigned gen = old / nloc;
        if (old + 1u == (gen + 1u) * nloc) {
            __builtin_amdgcn_fence(__ATOMIC_RELEASE, "agent");
            asm volatile("s_waitcnt vmcnt(0)" ::: "memory");
            const unsigned og = xb_add(&bar[XB_TOP], 1u);
            const unsigned tg = og / nx;
            if (og + 1u == (tg + 1u) * nx) xb_add(&bar[XB_TOPGEN], 1u);
            else XB_SPIN(xb_ld(&bar[XB_TOPGEN]) == tg, bar);
            __builtin_amdgcn_fence(__ATOMIC_ACQUIRE, "agent");
            xb_add(&bar[XB_XGEN(b.x)], 1u);
            asm volatile("s_waitcnt vmcnt(0)" ::: "memory");
        } else {
            XB_SPIN(xb_ld(&bar[XB_XGEN(b.x)]) == gen, bar);
            __builtin_amdgcn_fence(__ATOMIC_ACQUIRE, "agent");
            asm volatile("s_waitcnt vmcnt(0)" ::: "memory");
        }
    }
    __syncthreads();
}

__global__ void __launch_bounds__(NTHR, 2) fwd_megakernel(Args a) {
    extern __shared__ __attribute__((aligned(16))) unsigned char lds_raw[];
    LAS unsigned char* lds = (LAS unsigned char*)lds_raw;
    cg::grid_group grid = cg::this_grid();
    const int tid = threadIdx.x, lane = tid & 63, wave = __builtin_amdgcn_readfirstlane(tid >> 6);
    const int G = gridDim.x, c = blockIdx.x;
    volatile LAS unsigned* xst = (volatile LAS unsigned*)(lds + LDS_BYTES - 64);
    if (tid < 2) xst[tid] = 0u;
    __syncthreads();
    const XcdBarrier xbar = xcd_barrier_post((unsigned*)(a.ws + WS_CTL), xst);
#define SEAM() xcd_barrier(xbar)
    bf16_t* H = (bf16_t*)(a.ws + WS_H); bf16_t* PROJ = (bf16_t*)(a.ws + WS_PROJ); bf16_t* X1B = (bf16_t*)(a.ws + WS_X1B) + DM; bf16_t* ACT = (bf16_t*)(a.ws + WS_ACT); float* SSQ = (float*)(a.ws + WS_SSQ);
    const bf16_t* Win_t = (const bf16_t*)(a.ws + WS_WIN); const bf16_t* Wout_t = (const bf16_t*)(a.ws + WS_WOUT); const bf16_t* Wgu_t = (const bf16_t*)(a.ws + WS_WGU); const bf16_t* Wd_t = (const bf16_t*)(a.ws + WS_WD);

#ifndef PROBE_DUP
#define PROBE_DUP -1
#endif
#define NREP(k) ((PROBE_DUP == (k)) ? 2 : 1)
    for (int rep = 0; rep < NREP(0); ++rep) {
    p0_prologue(a, lds, lane, wave);
    if (a.cg_seam) grid.sync(); else SEAM();
    }
    if (PROBE_DUP == 7) { for (int rep = 0; rep < 10; ++rep) SEAM(); }
    for (int rep = 0; rep < NREP(1); ++rep)
    {
        pg8::Gemm g{H, Win_t, DM}; pg8::Order S; S.init(MTOK / 256, INW / 256, G, c, G == 256 ? 2 : 0);
        pg8::EpiBf16 E{PROJ, INW, SSQ + (size_t)MTOK * 17};
        pg8::gemm_phase<pg8::EpiBf16, false, true>(lds, g, S, E);
        if (G == 256) { if ((c & 7) >= 2) p0_convert(a, lds, lane, wave, P0_ITEMS_EARLY, P0_ITEMS_SPLIT, ((c >> 3) * 6 + (c & 7) - 2) * 8 + wave, 192 * 8); }
        else p0_convert(a, lds, lane, wave, P0_ITEMS_EARLY, P0_ITEMS_SPLIT, c * 8 + wave, G * 8);
        SEAM();
    }
    for (int rep = 0; rep < NREP(2); ++rep) {
    p2_attn_conv(a, lds, tid, lane, wave);
    SEAM();
    }
    for (int rep = 0; rep < NREP(3); ++rep)
    {
        pg8::Gemm g{(const bf16_t*)(a.ws + WS_MIX), Wout_t, DM}; pg8::Order S; S.init(MTOK / 256, DM / 256, G, c, 0);
        pg8::EpiRes1 E{H  , X1B, SSQ, (unsigned*)(a.ws + WS_CTL) + 6144, SSQ + (size_t)MTOK * 16};
        pg8::gemm_phase<pg8::EpiRes1, false, false>(lds, g, S, E);
        SEAM();
    }
    for (int rep = 0; rep < NREP(4); ++rep)
    {
        pg8::Gemm g{X1B, Wgu_t, DM}; pg8::Order S; S.init(34, 2 * FF / 256, G, c, 1);
        pg8::EpiFfn E{ACT, SSQ + (size_t)MTOK * 16, a.ffn_cw, a.ffn_cb};
        pg8::gemm_phase<pg8::EpiFfn, true, true>(lds, g, S, E);
        if (rep == 0) { const int nu = 34 * (2 * FF / 256), r = nu % G;
          const int wbase = r ? (c - r) : c, nw = r ? (G - r) : G;
          if (wbase >= 0) p0_convert(a, lds, lane, wave, P0_ITEMS_SPLIT, P0_ITEMS_ALL, wbase * 8 + wave, nw * 8); }
        SEAM();
    }
    {
        pg8::Gemm g{ACT, Wd_t, FF}; pg8::Order S; S.init(MTOK / 256, DM / 256, G, c, 0);
        pg8::EpiFinal E{X1B, a.out, SSQ + (size_t)MTOK * 8, (unsigned*)(a.ws + WS_CTL) + 4096, a.final_w};
        pg8::gemm_phase<pg8::EpiFinal, false, false>(lds, g, S, E);
    }
}

extern "C" void kernel_launch(void* const* d_in, const int* in_sizes, int n_in, void* d_out, int out_size, void* d_ws, size_t ws_size, hipStream_t stream) {
    static int grid = 0;
    if (grid == 0) {
        if (n_in != 16 || out_size != MTOK * DM || ws_size < WS_END) { fprintf(stderr, "kernel_launch: unexpected shapes (n_in %d, out %d, ws %zu)\n", n_in, out_size, ws_size); grid = -1; return; }
        int dev = 0, cus = 0, per_cu = 0;
        hipGetDevice(&dev); hipDeviceGetAttribute(&cus, hipDeviceAttributeMultiprocessorCount, dev);
        hipFuncSetAttribute((const void*)fwd_megakernel, hipFuncAttributeMaxDynamicSharedMemorySize, LDS_BYTES);
        hipOccupancyMaxActiveBlocksPerMultiprocessor(&per_cu, (const void*)fwd_megakernel, NTHR, LDS_BYTES);
        grid = cus * per_cu;
        if (grid != 256) { fprintf(stderr, "kernel_launch: resident capacity %d x %d; this kernel needs exactly 256 workgroups\n", cus, per_cu); if (grid > 256) grid = 256; else { grid = -1; return; } }
    }
    if (grid < 0) return;
    if (hipMemsetAsync((char*)d_ws + WS_CTL, 0, CTL_BYTES, stream) != hipSuccess) { fprintf(stderr, "kernel_launch: memset of the barrier words failed\n"); return; }
    Args a{};
    a.x = (const float*)d_in[0]; a.attn_norm_w = (const float*)d_in[1]; a.w_in = (const float*)d_in[2]; a.sink = (const float*)d_in[3]; a.mix_w = (const float*)d_in[4]; a.mix_b = (const float*)d_in[5];
    a.aon_w = (const float*)d_in[6]; a.con_w = (const float*)d_in[7]; a.w_out = (const float*)d_in[8]; a.ffn_norm_w = (const float*)d_in[9]; a.w_gate = (const float*)d_in[10]; a.w_up = (const float*)d_in[11];
    a.ffn_cw = (const float*)d_in[12]; a.ffn_cb = (const float*)d_in[13]; a.w_down = (const float*)d_in[14]; a.final_w = (const float*)d_in[15];
    a.out = (float*)d_out; a.ws = (unsigned char*)d_ws;
    void* args[] = {&a};
    hipError_t e = hipLaunchCooperativeKernel((const void*)fwd_megakernel, dim3(grid), dim3(NTHR), args, LDS_BYTES, stream);
    if (e != hipSuccess) fprintf(stderr, "cooperative launch failed: %s (grid %d)\n", hipGetErrorString(e), grid);
}
```
